# Optimizing an MI355X kernel written in HIP

```python
import jax, jax.numpy as jnp
from jax import lax
import numpy as np

D_MODEL = 2048
BATCH = 1
SEQ = 8192
DEPTH = 1

MEM_LEN = 256
HEAD_DIM = 128
N_CONV_GROUPS = 4
CONV_W = N_CONV_GROUPS * HEAD_DIM
CONV_K = 31
N_FOX_HEADS = 8
FOX_W = N_FOX_HEADS * HEAD_DIM
N_MEM_HEADS = 4
MEM_W = N_MEM_HEADS * HEAD_DIM
MIX_W = CONV_W + FOX_W + MEM_W
Q_BLOCK = 128
EPS = 1e-6
FORGET_BIAS_INIT = 2.0

SPLITS = (
    CONV_W,
    2 * CONV_W,
    3 * CONV_W,
    3 * CONV_W + FOX_W,
    3 * CONV_W + 2 * FOX_W,
    3 * CONV_W + 3 * FOX_W,
    3 * CONV_W + 3 * FOX_W + N_FOX_HEADS,
    3 * CONV_W + 4 * FOX_W + N_FOX_HEADS,
    3 * CONV_W + 4 * FOX_W + N_FOX_HEADS + MEM_W,
)
D_IN = 3 * CONV_W + 4 * FOX_W + N_FOX_HEADS + 2 * MEM_W

kernel_name = "hybrid_conformer_fox_memory_layer"


def rmsnorm(x, g):
    xf = x.astype(jnp.float32)
    y = xf * lax.rsqrt(jnp.mean(xf * xf, axis=-1, keepdims=True) + EPS)
    return (y * g.astype(jnp.float32)).astype(x.dtype)


def layernorm(x, g, b):
    xf = x.astype(jnp.float32)
    mu = jnp.mean(xf, axis=-1, keepdims=True)
    var = jnp.mean(jnp.square(xf - mu), axis=-1, keepdims=True)
    y = (xf - mu) * lax.rsqrt(var + EPS)
    return (y * g.astype(jnp.float32) + b.astype(jnp.float32)).astype(x.dtype)


def causal_depthwise_conv(u, w, b):
    y = lax.conv_general_dilated(
        u, w[:, None, :], window_strides=(1,), padding=[(CONV_K - 1, 0)],
        dimension_numbers=('NWC', 'WIO', 'NWC'), feature_group_count=u.shape[-1])
    return y + b


def fox_attention(q, k, v, logf):
    B, S, H, Dh = q.shape
    nb = S // Q_BLOCK
    cT = jnp.cumsum(logf, axis=1).transpose(0, 2, 1)
    qb = q.reshape(B, nb, Q_BLOCK, H, Dh).transpose(1, 0, 2, 3, 4)
    cb = cT.reshape(B, H, nb, Q_BLOCK).transpose(2, 0, 1, 3)
    k_pos = jnp.arange(S)
    scale = Dh ** -0.5

    def block(args):
        i, qi, ci = args
        s = jnp.einsum('bqhd,bkhd->bhqk', qi, k).astype(jnp.float32) * scale
        bias = ci[..., :, None] - cT[..., None, :]
        q_pos = i * Q_BLOCK + jnp.arange(Q_BLOCK)
        mask = k_pos[None, :] <= q_pos[:, None]
        s = jnp.where(mask, s + bias, -jnp.inf)
        p = jax.nn.softmax(s, axis=-1).astype(v.dtype)
        return jnp.einsum('bhqk,bkhd->bqhd', p, v)

    out = lax.map(block, (jnp.arange(nb), qb, cb))
    return out.transpose(1, 0, 2, 3, 4).reshape(B, S, H * Dh)


def memory_attention(q, mk, mv):
    B, S, H, Dh = q.shape
    s = jnp.einsum('bshd,bmhd->bhsm', q, mk).astype(jnp.float32) * (Dh ** -0.5)
    p = jax.nn.softmax(s, axis=-1).astype(mv.dtype)
    return jnp.einsum('bhsm,bmhd->bshd', p, mv).reshape(B, S, H * Dh)


def setup_inputs(seed: int = 0) -> dict:
    key = jax.random.key(seed)
    ks = jax.random.split(key, 16)
    n = jax.random.normal
    f32 = jnp.float32
    return {
        "x": n(ks[0], (BATCH, SEQ, D_MODEL), f32),
        "mem": n(ks[1], (BATCH, MEM_LEN, D_MODEL), f32),
        "norm_g": 1.0 + 0.05 * n(ks[2], (DEPTH, D_MODEL), f32),
        "mem_norm_g": 1.0 + 0.05 * n(ks[3], (DEPTH, D_MODEL), f32),
        "w_in": n(ks[4], (DEPTH, D_MODEL, D_IN), f32) * D_MODEL ** -0.5,
        "b_f": FORGET_BIAS_INIT + 0.1 * n(ks[5], (DEPTH, N_FOX_HEADS), f32),
        "conv_w": n(ks[6], (DEPTH, CONV_K, CONV_W), f32) * CONV_K ** -0.5,
        "conv_b": 0.02 * n(ks[7], (DEPTH, CONV_W), f32),
        "conv_ln_g": 1.0 + 0.05 * n(ks[8], (DEPTH, CONV_W), f32),
        "conv_ln_b": 0.02 * n(ks[9], (DEPTH, CONV_W), f32),
        "w_conv_pw": n(ks[10], (DEPTH, CONV_W, CONV_W), f32) * CONV_W ** -0.5,
        "w_mem_kv": n(ks[11], (DEPTH, D_MODEL, 2 * MEM_W), f32) * D_MODEL ** -0.5,
        "w_out": n(ks[12], (DEPTH, MIX_W, D_MODEL), f32) * MIX_W ** -0.5,
        "final_g": 1.0 + 0.05 * n(ks[13], (D_MODEL,), f32),
    }


def reference(x, mem, norm_g, mem_norm_g, w_in, b_f, conv_w, conv_b, conv_ln_g,
              conv_ln_b, w_conv_pw, w_mem_kv, w_out, final_g):
    B, S, _ = x.shape
    for l in range(DEPTH):
        h = rmsnorm(x, norm_g[l])
        proj = h @ w_in[l]
        (cv_a, cv_b, cv_gate, fq, fk, fv, f_logit, fox_gate,
         mq, mem_gate) = jnp.split(proj, SPLITS, axis=-1)

        u = cv_a * jax.nn.sigmoid(cv_b)
        u = causal_depthwise_conv(u, conv_w[l], conv_b[l])
        u = jax.nn.silu(layernorm(u, conv_ln_g[l], conv_ln_b[l]))
        y_conv = (u @ w_conv_pw[l]) * jax.nn.silu(cv_gate)

        logf = jax.nn.log_sigmoid(f_logit.astype(jnp.float32) + b_f[l].astype(jnp.float32))
        shp = (B, S, N_FOX_HEADS, HEAD_DIM)
        y_fox = fox_attention(fq.reshape(shp), fk.reshape(shp), fv.reshape(shp), logf)
        y_fox = y_fox * jax.nn.silu(fox_gate)

        mkv = rmsnorm(mem, mem_norm_g[l]) @ w_mem_kv[l]
        mk, mv = jnp.split(mkv, 2, axis=-1)
        mshp = (B, mem.shape[1], N_MEM_HEADS, HEAD_DIM)
        y_mem = memory_attention(mq.reshape(B, S, N_MEM_HEADS, HEAD_DIM),
                                 mk.reshape(mshp), mv.reshape(mshp))
        y_mem = y_mem * jax.nn.silu(mem_gate)

        y = jnp.concatenate([y_conv, y_fox, y_mem], axis=-1)
        x = x + y @ w_out[l]
    return rmsnorm(x, final_g)
```

```cpp
#include <hip/hip_runtime.h>
#include <hip/hip_cooperative_groups.h>
#include <cstdio>
#include <cstdint>
namespace cg = cooperative_groups;

namespace pg8 {
#define PG8_LAS __attribute__((address_space(3)))
typedef unsigned short bf16_t;
typedef short bf16x8 __attribute__((ext_vector_type(8)));
typedef float f32x4 __attribute__((ext_vector_type(4)));
typedef unsigned u32x4 __attribute__((ext_vector_type(4)));
constexpr int BM = 256, BK = 64, HALF = 128, HTB = HALF * BK * 2  , STAGE_BYTES = 8 * HTB, NXCD = 8, WGM = 8;

__host__ __device__ __forceinline__ int lds_byte(int r, int c) { const int st = (r >> 4) * 2 + (c >> 5), rr = r & 15, cc = c & 31, ob = rr * 64 + cc * 2; return st * 1024 + (ob ^ (((ob >> 9) & 1) << 5)); }
__host__ __device__ __forceinline__ void stage_rc(int b, int& R, int& C) { const int st = b / 1024, sb = b % 1024, swz = sb ^ (((sb >> 9) & 1) << 5); R = (st >> 1) * 16 + swz / 64; C = (st & 1) * 32 + (swz % 64) / 2; }
__host__ __device__ __forceinline__ int perm32(int rho) { const int n = rho >> 4, i = rho & 15; return 8 * (i >> 2) + 4 * n + (i & 3); }

struct Unit { int pm, pn; };
struct Gemm { const bf16_t* A; const bf16_t* Bt; int M, N, K; };

struct StaticOrder {
    int nM, nN, nwg, G, c;
    __host__ __device__ void init(int M, int N, int G_, int c_) { nM = M / BM; nN = N / BM; nwg = nM * nN; G = G_; c = c_; }
    __host__ __device__ bool next(int i, Unit& u) const {
        const long L = (long)i * G + c; if (L >= nwg) return false;
        int wgid = (int)L; { const int q = nwg / NXCD, r = nwg % NXCD, xcd = wgid % NXCD, off = wgid / NXCD; wgid = (xcd < r ? xcd * (q + 1) : r * (q + 1) + (xcd - r) * q) + off; }
        const int nig = WGM * nN, gid = wgid / nig, fm = gid * WGM, gsz = (nM - fm) < WGM ? (nM - fm) : WGM;
        u.pm = fm + ((wgid % nig) % gsz); u.pn = (wgid % nig) / gsz; return true;
    }
    __device__ __forceinline__ void a_ready(const Unit&) const {}
    __device__ __forceinline__ void done(const Unit&) const {}
};

__device__ __forceinline__ unsigned cvt_pk_bf16(float lo, float hi) { unsigned r; asm volatile("v_cvt_pk_bf16_f32 %0, %1, %2" : "=v"(r) : "v"(lo), "v"(hi)); return r; }
typedef float f32x2 __attribute__((ext_vector_type(2)));
template <class Epi, class Sched, bool ALIGN_EPI = false, bool SP2 = false>
__device__ __forceinline__ void gemm_phase(PG8_LAS unsigned char* lds, const Gemm g, const Sched& S, const Epi& E, const int wv_) {
    const int wid = wv_, lane = (int)__builtin_amdgcn_mbcnt_hi(~0u, __builtin_amdgcn_mbcnt_lo(~0u, 0u)), tid = wid * 64 + lane, wr = wid >> 2, wc = wid & 3, fr = lane & 15, fq = lane >> 4;
    const int K = g.K, nt = K / BK;
    unsigned voffA[2], voffB[2];
#pragma unroll
    for (int i = 0; i < 2; ++i) { int R, C; stage_rc(tid * 16 + i * 8192, R, C); const int Rb = Epi::PERM ? ((R & ~31) + perm32(R & 31)) : R;
        voffA[i] = (unsigned)(R * K + C) * 2u; voffB[i] = (unsigned)(Rb * K + C) * 2u; }
    const size_t kstep = (size_t)(BK * 2);
    const size_t hstep = (size_t)HALF * K * 2;
    const size_t tstep = 2 * hstep;
    const unsigned ldsw = (unsigned)wid * 1024u;
    const int aoff = lds_byte(wr * 64 + fr, fq * 8), boff = lds_byte(wc * 32 + fr, fq * 8);
#define PG8_SA(b, h) (((b) * 2 + (h)) * HTB)
#define PG8_SB(b, h) ((4 + (b) * 2 + (h)) * HTB)
#define PG8_STAGE(bufoff, gbase, voff) do { _Pragma("unroll") for (int _i = 0; _i < 2; ++_i) \
        __builtin_amdgcn_global_load_lds((const unsigned*)((const char*)(gbase) + (voff)[_i]), (PG8_LAS unsigned*)(lds + (bufoff) + ldsw + _i * 8192), 16, 0, 0); } while (0)
#define PG8_LDA(dst, b, h) do { _Pragma("unroll") for (int m = 0; m < 4; ++m) _Pragma("unroll") for (int k = 0; k < 2; ++k) dst[m][k] = *(const PG8_LAS bf16x8*)(lds + PG8_SA(b, h) + aoff + m * 2048 + k * 1024); } while (0)
#define PG8_LDB(dst, b, h) do { _Pragma("unroll") for (int n = 0; n < 2; ++n) _Pragma("unroll") for (int k = 0; k < 2; ++k) dst[n][k] = *(const PG8_LAS bf16x8*)(lds + PG8_SB(b, h) + boff + n * 2048 + k * 1024); } while (0)
#define PG8_MMA(ai, bj, At, Bt) do { __builtin_amdgcn_s_setprio(1); _Pragma("unroll") for (int m = 0; m < 4; ++m) _Pragma("unroll") for (int n = 0; n < 2; ++n) _Pragma("unroll") for (int k = 0; k < 2; ++k) \
        acc[ai][bj][m][n] = __builtin_amdgcn_mfma_f32_16x16x32_bf16(Bt[n][k], At[m][k], acc[ai][bj][m][n], 0, 0, 0); __builtin_amdgcn_s_setprio(0); } while (0)
#define PG8_WAIT_V(n) asm volatile("s_waitcnt vmcnt(" #n ")" ::: "memory")
#define PG8_WAIT_L(n) asm volatile("s_waitcnt lgkmcnt(" #n ")" ::: "memory")
#define PG8_BAR __builtin_amdgcn_s_barrier()
#define PG8_SCHED __builtin_amdgcn_sched_barrier(0)
    Unit cur, nxt; int ui = 0;
    if (!S.next(0, cur)) return;
    f32x4 acc[2][2][4][2];
#pragma unroll
    for (int a = 0; a < 2; ++a)
#pragma unroll
        for (int b = 0; b < 2; ++b)
#pragma unroll
            for (int m = 0; m < 4; ++m)
#pragma unroll
                for (int n = 0; n < 2; ++n) acc[a][b][m][n] = (f32x4){0.f, 0.f, 0.f, 0.f};
    bf16x8 At[4][2], B0[2][2], B1[2][2];
    const char* cA = (const char*)g.A + (size_t)cur.pm * tstep; const char* cB = (const char*)g.Bt + (size_t)cur.pn * tstep;
    S.a_ready(cur);
    if constexpr (SP2) {
        PG8_STAGE(PG8_SB(0, 0), cB, voffB); PG8_STAGE(PG8_SB(0, 1), cB + hstep, voffB); PG8_STAGE(PG8_SA(0, 0), cA, voffA); PG8_STAGE(PG8_SA(0, 1), cA + hstep, voffA);
        if (wr == 1) PG8_BAR;
        PG8_WAIT_V(2); PG8_BAR;
        PG8_STAGE(PG8_SB(1, 0), cB + kstep, voffB); PG8_STAGE(PG8_SA(1, 0), cA + kstep, voffA); PG8_STAGE(PG8_SB(1, 1), cB + hstep + kstep, voffB);
        PG8_WAIT_V(6); PG8_BAR;
    } else {
        PG8_STAGE(PG8_SB(0, 0), cB, voffB); PG8_STAGE(PG8_SA(0, 0), cA, voffA); PG8_STAGE(PG8_SB(0, 1), cB + hstep, voffB); PG8_STAGE(PG8_SA(0, 1), cA + hstep, voffA);
        if (wr == 1) PG8_BAR;
        PG8_WAIT_V(4); PG8_BAR;
        PG8_STAGE(PG8_SB(1, 0), cB + kstep, voffB); PG8_STAGE(PG8_SA(1, 0), cA + kstep, voffA); PG8_STAGE(PG8_SB(1, 1), cB + hstep + kstep, voffB);
        PG8_WAIT_V(6); PG8_BAR;
    }
    for (;;) {
        const bool has_next = S.next(ui + 1, nxt);
        const char* nA = has_next ? (const char*)g.A + (size_t)nxt.pm * tstep : cA; const char* nB = has_next ? (const char*)g.Bt + (size_t)nxt.pn * tstep : cB;
        for (int t = 0; t < nt; t += 2) {
            const bool last = (t == nt - 2);
            const char* a1 = cA + (size_t)(t + 1) * kstep;
            const char* a2 = last ? nA : cA + (size_t)(t + 2) * kstep; const char* b2 = last ? nB : cB + (size_t)(t + 2) * kstep;
            const char* a3 = a2 + kstep; const char* b3 = b2 + kstep;
            if (last && has_next) S.a_ready(nxt);
            if constexpr (SP2) {
            PG8_LDB(B0, 0, 0); PG8_LDB(B1, 0, 1); PG8_SCHED; PG8_LDA(At, 0, 0); PG8_STAGE(PG8_SA(1, 1), a1 + hstep, voffA);
            PG8_WAIT_V(8); PG8_WAIT_L(0); PG8_BAR; PG8_MMA(0, 0, At, B0); PG8_MMA(0, 1, At, B1); PG8_BAR; PG8_SCHED;
            PG8_LDA(At, 0, 1); PG8_STAGE(PG8_SB(0, 0), b2, voffB); PG8_STAGE(PG8_SB(0, 1), b2 + hstep, voffB); PG8_STAGE(PG8_SA(0, 0), a2, voffA);
            PG8_WAIT_V(8); PG8_WAIT_L(0); PG8_BAR; PG8_MMA(1, 0, At, B0); PG8_MMA(1, 1, At, B1); PG8_BAR; PG8_SCHED;
            PG8_LDB(B0, 1, 0); PG8_LDB(B1, 1, 1); PG8_SCHED; PG8_LDA(At, 1, 0); PG8_STAGE(PG8_SA(0, 1), a2 + hstep, voffA);
            PG8_WAIT_V(8); PG8_WAIT_L(0); PG8_BAR; PG8_MMA(0, 0, At, B0); PG8_MMA(0, 1, At, B1); PG8_BAR; PG8_SCHED;
            PG8_LDA(At, 1, 1); PG8_STAGE(PG8_SB(1, 0), b3, voffB); PG8_STAGE(PG8_SB(1, 1), b3 + hstep, voffB); PG8_STAGE(PG8_SA(1, 0), a3, voffA);
            PG8_WAIT_V(8); PG8_WAIT_L(0); PG8_BAR; PG8_MMA(1, 0, At, B0); PG8_MMA(1, 1, At, B1); PG8_BAR; PG8_SCHED;
            } else {
            PG8_LDB(B0, 0, 0); PG8_SCHED; PG8_LDA(At, 0, 0); PG8_STAGE(PG8_SA(1, 1), a1 + hstep, voffA);
            PG8_WAIT_L(8); PG8_BAR; PG8_WAIT_L(0); PG8_MMA(0, 0, At, B0); PG8_BAR; PG8_SCHED;
            PG8_LDB(B1, 0, 1); PG8_STAGE(PG8_SB(0, 0), b2, voffB);
            PG8_BAR; PG8_WAIT_L(0); PG8_MMA(0, 1, At, B1); PG8_BAR;
            PG8_LDA(At, 0, 1); PG8_STAGE(PG8_SA(0, 0), a2, voffA);
            PG8_BAR; PG8_WAIT_L(0); PG8_MMA(1, 0, At, B0); PG8_BAR; PG8_SCHED;
            PG8_STAGE(PG8_SB(0, 1), b2 + hstep, voffB);
            PG8_WAIT_V(6); PG8_BAR; PG8_MMA(1, 1, At, B1); PG8_BAR;
            PG8_LDB(B0, 1, 0); PG8_SCHED; PG8_LDA(At, 1, 0); PG8_STAGE(PG8_SA(0, 1), a2 + hstep, voffA);
            PG8_WAIT_L(8); PG8_BAR; PG8_WAIT_L(0); PG8_MMA(0, 0, At, B0); PG8_BAR; PG8_SCHED;
            PG8_LDB(B1, 1, 1); PG8_STAGE(PG8_SB(1, 0), b3, voffB);
            PG8_BAR; PG8_WAIT_L(0); PG8_MMA(0, 1, At, B1); PG8_BAR;
            PG8_LDA(At, 1, 1); PG8_STAGE(PG8_SA(1, 0), a3, voffA);
            PG8_BAR; PG8_WAIT_L(0); PG8_MMA(1, 0, At, B0); PG8_BAR; PG8_SCHED;
            PG8_STAGE(PG8_SB(1, 1), b3 + hstep, voffB);
            PG8_WAIT_V(6); PG8_BAR; PG8_MMA(1, 1, At, B1); PG8_BAR;
            }
        }
        if constexpr (ALIGN_EPI) { if (wr == 0) PG8_BAR; }
        if constexpr (!Epi::AFTER_DRAIN) { E(acc, cur, wr, wc, fr, fq); S.done(cur); }
        if (!has_next) break;
#pragma unroll
        for (int a = 0; a < 2; ++a)
#pragma unroll
            for (int b = 0; b < 2; ++b)
#pragma unroll
                for (int m = 0; m < 4; ++m)
#pragma unroll
                    for (int n = 0; n < 2; ++n) acc[a][b][m][n] = (f32x4){0.f, 0.f, 0.f, 0.f};
        cur = nxt; cA = nA; cB = nB; ++ui;
        if constexpr (ALIGN_EPI) { if (wr == 1) PG8_BAR; }
    }
    PG8_WAIT_V(0);
    if constexpr (!ALIGN_EPI) { if (wr == 0) PG8_BAR; }
    PG8_BAR;
    if constexpr (Epi::AFTER_DRAIN) { E.fused(acc, cur, wr, wc, fr, fq, lds, wid, lane); S.done(cur); }
#undef PG8_SA
#undef PG8_SB
#undef PG8_STAGE
#undef PG8_LDA
#undef PG8_LDB
#undef PG8_MMA
#undef PG8_WAIT_V
#undef PG8_WAIT_L
#undef PG8_BAR
#undef PG8_SCHED
}
}

#define LAS __attribute__((address_space(3)))
typedef unsigned short bf16_t;
typedef short bf16x8 __attribute__((ext_vector_type(8)));
typedef short s16x4 __attribute__((ext_vector_type(4)));
typedef float f32x4 __attribute__((ext_vector_type(4)));
typedef float f32x16 __attribute__((ext_vector_type(16)));
typedef unsigned u32x4 __attribute__((ext_vector_type(4)));
typedef unsigned u32x2 __attribute__((ext_vector_type(2)));

constexpr int SEQ = 8192, DM = 2048, DIN = 6664, NP = 6656, MEMLEN = 256, FCOL = 4608;
constexpr int C_CVA = 0, C_CVB = 512, C_CVG = 1024, C_FQ = 1536, C_FK = 2560, C_FV = 3584, C_FG = 4608, C_MQ = 5632, C_MG = 6144;
constexpr int Y_CONV = 0, Y_FOX = 512, Y_MEM = 1536;
constexpr float EPS = 1e-6f;
constexpr size_t MiB = 1u << 20;
constexpr size_t WS_BAR = 64 * 1024;
constexpr size_t WS_SS = 0, WS_LOGF = 1 * MiB, WS_CS = 1 * MiB + 512 * 1024;
constexpr size_t WS_A = 2 * MiB;
constexpr size_t WS_MEMN = WS_A + 32 * MiB;
constexpr size_t WS_B = 36 * MiB;
constexpr size_t WS_WKV = WS_B + 26 * MiB;
constexpr size_t WS_WOUT = 66 * MiB, WS_WPW = 74 * MiB, WS_MKV = 75 * MiB, WS_P = 76 * MiB, WS_Y = 180 * MiB, WS_END = 212 * MiB;
constexpr int LDS_BYTES = 147456;

__device__ __forceinline__ unsigned f2bf(float f) { unsigned u = __builtin_bit_cast(unsigned, f); return (u + 0x7fffu + ((u >> 16) & 1u)) >> 16; }
__device__ __forceinline__ unsigned pk2(float lo, float hi) { return f2bf(lo) | (f2bf(hi) << 16); }
__device__ __forceinline__ float bf2f(unsigned short b) { return __builtin_bit_cast(float, (unsigned)b << 16); }
__device__ __forceinline__ float sigmoidf_(float x) { return 1.f / (1.f + __expf(-x)); }
__device__ __forceinline__ float wave_sum(float v) {
#pragma unroll
    for (int o = 1; o < 64; o <<= 1) v += __shfl_xor(v, o);
    return v;
}
#define LD8(p) (*reinterpret_cast<const bf16x8*>(p))
__device__ __forceinline__ int lane_id() { return (int)__builtin_amdgcn_mbcnt_hi(~0u, __builtin_amdgcn_mbcnt_lo(~0u, 0u)); }

struct Sched1 {
    int G, c;
    __device__ __forceinline__ bool next(int i, pg8::Unit& u) const {
        const int L = i * G + c; if (L >= 836) return false;
        if (L >= 832) { u.pm = 32; u.pn = 26 + (L - 832); return true; }
        constexpr int nM = 32, nN = 26, nwg = 832, NX = 8, WGM = 8;
        int wgid = L; { const int q = nwg / NX, r = nwg % NX, xcd = wgid % NX, off = wgid / NX; wgid = (xcd < r ? xcd * (q + 1) : r * (q + 1) + (xcd - r) * q) + off; }
        const int nig = WGM * nN, gid = wgid / nig, fm = gid * WGM, gsz = (nM - fm) < WGM ? (nM - fm) : WGM;
        u.pm = fm + ((wgid % nig) % gsz); u.pn = (wgid % nig) / gsz; return true;
    }
    __device__ __forceinline__ void a_ready(const pg8::Unit&) const {}
    __device__ __forceinline__ void done(const pg8::Unit&) const {}
};
struct Epi1 {
    static constexpr bool PERM = true, AFTER_DRAIN = false;
    bf16_t* P; bf16_t* MKV;
    __device__ __forceinline__ void operator()(const pg8::f32x4 (&acc)[2][2][4][2], const pg8::Unit& u, int wr, int wc, int fr, int fq) const {
        bf16_t* base; int ldc, colt, row0;
        if (u.pm == 32) { base = MKV; ldc = 1024; colt = (u.pn - 26) * 256; row0 = wr * 64 + fr; }
        else { base = P; ldc = NP; colt = u.pn * 256; row0 = u.pm * 256 + wr * 64 + fr; }
        const int col0 = colt + wc * 32 + 8 * fq;
#pragma unroll
        for (int ai = 0; ai < 2; ++ai)
#pragma unroll
            for (int m = 0; m < 4; ++m) { bf16_t* rowp = base + (size_t)(row0 + ai * 128 + m * 16) * ldc + col0;
#pragma unroll
                for (int bj = 0; bj < 2; ++bj) { const pg8::f32x4 v0 = acc[ai][bj][m][0], v1 = acc[ai][bj][m][1];
                    u32x4 w; w.x = pg8::cvt_pk_bf16(v0[0], v0[1]); w.y = pg8::cvt_pk_bf16(v0[2], v0[3]); w.z = pg8::cvt_pk_bf16(v1[0], v1[1]); w.w = pg8::cvt_pk_bf16(v1[2], v1[3]);
                    *(u32x4*)(rowp + bj * 128) = w; } }
    }
};
struct Epi2 {
    static constexpr bool PERM = false, AFTER_DRAIN = false;
    const float* x; float* out; float* ss;
    __device__ __forceinline__ void operator()(const pg8::f32x4 (&acc)[2][2][4][2], const pg8::Unit& u, int wr, int wc, int fr, int fq) const {
        const int col0 = u.pn * 256 + wc * 32 + 4 * fq;
#pragma unroll
        for (int ai = 0; ai < 2; ++ai)
#pragma unroll
            for (int m = 0; m < 4; ++m) { const int row = u.pm * 256 + ai * 128 + wr * 64 + m * 16 + fr; const size_t off = (size_t)row * DM + col0; float q = 0.f;
#pragma unroll
                for (int bj = 0; bj < 2; ++bj)
#pragma unroll
                    for (int n = 0; n < 2; ++n) { const f32x4 xv = *(const f32x4*)(x + off + bj * 128 + n * 16); const f32x4 o = xv + acc[ai][bj][m][n];
                        *(f32x4*)(out + off + bj * 128 + n * 16) = o; q += (o[0] * o[0] + o[1] * o[1]) + (o[2] * o[2] + o[3] * o[3]); }
                q += __shfl_xor(q, 16); q += __shfl_xor(q, 32);
                if (fq == 0) atomicAdd(ss + row, q);
                if (m & 1) asm volatile("" ::: "memory"); }
    }
};

namespace att {
constexpr int D = 128, NW = 8, QBLK = 32, KVBLK = 64, QB = NW * QBLK;
constexpr int SHM_V = KVBLK * D * 2, SHM_K = KVBLK * D * 2;
constexpr int LDS_C = 2 * SHM_V + 2 * SHM_K + NW * 64 * 4;
constexpr int LDS_ATT = LDS_C + 8192 * 4;
constexpr float SCALE = 0.08838834764831845f, THR = 8.f;
constexpr unsigned WBIG = 0x40000000u;
#define KSWZ(row, colB) ((row) * 256 + ((colB) ^ (((row) & 7) << 4)))
#define SBAR() __builtin_amdgcn_sched_barrier(0)
__device__ __forceinline__ int v_st(int k, int c) { const int kk = (k & ~0xC) | ((k & 4) << 1) | ((k & 8) >> 1); return ((kk >> 3) * 4 + (c >> 5)) * 512 + ((kk & 7) * 32 + (c & 31)) * 2; }
__device__ __forceinline__ int v_rd_base(int lane) { return ((lane & 3) << 3) | (((lane >> 2) & 3) << 6) | (((lane >> 4) & 1) << 5) | (((lane >> 5) & 1) << 8); }
constexpr int v_rd_off(int d0, int ks, int half) { return d0 * 512 + ks * 4096 + half * 2048; }
__device__ __forceinline__ int crow(int r, int hi) { return (r & 3) + 8 * (r >> 2) + 4 * hi; }
__device__ __forceinline__ unsigned cvtpk(float lo, float hi) { unsigned r; asm volatile("v_cvt_pk_bf16_f32 %0, %1, %2" : "=v"(r) : "v"(lo), "v"(hi)); return r; }
__device__ __forceinline__ void mask_tile(f32x16& p0, f32x16& p1, int dq, unsigned W) {
    const float NEG = -__builtin_inff();
#pragma unroll
    for (int r = 0; r < 16; ++r) {
        const int c = (r & 3) + 8 * (r >> 2);
        if ((unsigned)(dq - c) >= W) p0[r] = NEG;
        if ((unsigned)(dq - c - 32) >= W) p1[r] = NEG;
    }
}
__device__ __forceinline__ void partialSM(f32x16& p0, f32x16& p1, float& m_reg, float& mn, float& alpha) {
    float pmax = p0[0];
#pragma unroll
    for (int r = 1; r < 16; ++r) pmax = fmaxf(pmax, p0[r]);
#pragma unroll
    for (int r = 0; r < 16; ++r) pmax = fmaxf(pmax, p1[r]);
    { auto rr = __builtin_amdgcn_permlane32_swap(__float_as_uint(pmax), __float_as_uint(pmax), false, false);
      pmax = fmaxf(__uint_as_float(rr[0]), __uint_as_float(rr[1])); }
    constexpr float C2 = 1.4426950408889634f * SCALE;
    if (__builtin_expect(__all((pmax - m_reg) * SCALE <= THR), 1)) { mn = m_reg; alpha = 1.f; }
    else { mn = fmaxf(m_reg, pmax); alpha = __builtin_amdgcn_exp2f((m_reg - mn) * C2); m_reg = mn; }
    const float mnL = -mn * C2;
#pragma unroll
    for (int r = 0; r < 16; ++r) p0[r] = fmaf(p0[r], C2, mnL);
#pragma unroll
    for (int r = 0; r < 16; ++r) p1[r] = fmaf(p1[r], C2, mnL);
#pragma unroll
    for (int r = 0; r < 16; ++r) p0[r] = __builtin_amdgcn_exp2f(p0[r]);
}
__device__ __forceinline__ void finishSM(f32x16& p0, f32x16& p1, float alpha, float& l_reg, bf16x8& pa0, bf16x8& pa1, bf16x8& pa2, bf16x8& pa3) {
#pragma unroll
    for (int r = 0; r < 16; ++r) p1[r] = __builtin_amdgcn_exp2f(p1[r]);
    float ps = 0;
#pragma unroll
    for (int r = 0; r < 16; ++r) ps += p0[r];
#pragma unroll
    for (int r = 0; r < 16; ++r) ps += p1[r];
    { auto rr = __builtin_amdgcn_permlane32_swap(__float_as_uint(ps), __float_as_uint(ps), false, false);
      ps = __uint_as_float(rr[0]) + __uint_as_float(rr[1]); }
    l_reg = l_reg * alpha + ps;
#define PK4(P, B_, OUT) do { unsigned a0 = cvtpk(P[B_+0], P[B_+1]), a1 = cvtpk(P[B_+2], P[B_+3]);                          \
        unsigned b0 = cvtpk(P[B_+4], P[B_+5]), b1 = cvtpk(P[B_+6], P[B_+7]);                                             \
        auto r0 = __builtin_amdgcn_permlane32_swap(a0, b0, false, false); auto r1 = __builtin_amdgcn_permlane32_swap(a1, b1, false, false); \
        u32x4 w = {r0[0], r1[0], r0[1], r1[1]}; OUT = *reinterpret_cast<bf16x8*>(&w); } while (0)
    PK4(p0, 0, pa0); PK4(p0, 8, pa1); PK4(p1, 0, pa2); PK4(p1, 8, pa3);
#undef PK4
}
template <int KB>
__device__ __forceinline__ void qkt(f32x16& p0, f32x16& p1, const char* K_lds, int r32, int hi, const bf16x8* qr, const float* cb, float cq) {
#ifdef ATT_NO_BIAS
    p0 = f32x16{}; p1 = f32x16{};
#else
#pragma unroll
    for (int g = 0; g < 4; ++g) { const f32x4 a = *(const f32x4*)(cb + 8 * g), b = *(const f32x4*)(cb + 32 + 8 * g);
#pragma unroll
        for (int j = 0; j < 4; ++j) { p0[4 * g + j] = cq - a[j]; p1[4 * g + j] = cq - b[j]; } }
#endif
    const char* kb[4];
#pragma unroll
    for (int dd = 0; dd < 4; ++dd) kb[dd] = K_lds + KB * SHM_K + KSWZ(r32, (dd * 16 + hi * 8) * 2);
#pragma unroll
    for (int d0 = 0; d0 < 8; ++d0) { const char* a = kb[d0 & 3] + (d0 >> 2) * 128;
        bf16x8 b0 = *reinterpret_cast<const bf16x8*>(a);
        bf16x8 b1 = *reinterpret_cast<const bf16x8*>(a + 32 * 256);
        p0 = __builtin_amdgcn_mfma_f32_32x32x16_bf16(b0, qr[d0], p0, 0, 0, 0);
        p1 = __builtin_amdgcn_mfma_f32_32x32x16_bf16(b1, qr[d0], p1, 0, 0, 0); }
}
template <int VB>
__device__ __forceinline__ void pv_tile(f32x16* o, int vb0, bf16x8 pa0, bf16x8 pa1, bf16x8 pa2, bf16x8 pa3) {
#define TRRD(dst, off) asm volatile("ds_read_b64_tr_b16 %0, %1 offset:%2" : "=&v"(dst) : "v"(vb0), "i"(off) : "memory")
#define PV_D0(d0) do { s16x4 l0, l1, l2, l3, h0, h1, h2, h3; constexpr int b_ = VB * SHM_V + v_rd_off(d0, 0, 0); \
        TRRD(l0, b_); TRRD(h0, b_ + 2048); TRRD(l1, b_ + 4096); TRRD(h1, b_ + 6144); TRRD(l2, b_ + 8192); TRRD(h2, b_ + 10240); TRRD(l3, b_ + 12288); TRRD(h3, b_ + 14336); \
        asm volatile("s_waitcnt lgkmcnt(0)" ::: "memory"); SBAR(); \
        o[d0] = __builtin_amdgcn_mfma_f32_32x32x16_bf16(pa0, (bf16x8){l0[0], l0[1], l0[2], l0[3], h0[0], h0[1], h0[2], h0[3]}, o[d0], 0, 0, 0);   \
        o[d0] = __builtin_amdgcn_mfma_f32_32x32x16_bf16(pa1, (bf16x8){l1[0], l1[1], l1[2], l1[3], h1[0], h1[1], h1[2], h1[3]}, o[d0], 0, 0, 0);   \
        o[d0] = __builtin_amdgcn_mfma_f32_32x32x16_bf16(pa2, (bf16x8){l2[0], l2[1], l2[2], l2[3], h2[0], h2[1], h2[2], h2[3]}, o[d0], 0, 0, 0);   \
        o[d0] = __builtin_amdgcn_mfma_f32_32x32x16_bf16(pa3, (bf16x8){l3[0], l3[1], l3[2], l3[3], h3[0], h3[1], h3[2], h3[3]}, o[d0], 0, 0, 0); } while (0)
    PV_D0(0); PV_D0(1); PV_D0(2); PV_D0(3);
#undef PV_D0
#undef TRRD
}
struct BlockRef { const bf16_t* Q; const bf16_t* K; const float* C; bf16_t* O; int voff, goff, P0, skv, pkv, jlo, c0i; };
struct Seam { bf16x8 qr[8]; bf16x8 st_v0, st_v1, st_k0, st_k1; };
#define VMW() asm volatile("s_waitcnt vmcnt(0)" ::: "memory")
#define VMWN(n) asm volatile("s_waitcnt vmcnt(%0)" :: "i"(n) : "memory")
#define SLOAD_H(Kp, Vp, pitch, k0, roff) do { const char* kb_ = (const char*)(Kp) + (size_t)(k0) * (size_t)(pitch) * 2; const char* vb_ = (const char*)(Vp) + (size_t)(k0) * (size_t)(pitch) * 2; \
        S.st_v0 = LD8(vb_ + (roff)); S.st_v1 = LD8(vb_ + (size_t)(pitch) * 64 + (roff)); S.st_k0 = LD8(kb_ + (roff)); S.st_k1 = LD8(kb_ + (size_t)(pitch) * 64 + (roff)); } while (0)
#define SWRITE_HK(bf) do { *(bf16x8*)(K_lds + (bf) * SHM_K + kws) = S.st_k0; *(bf16x8*)(K_lds + (bf) * SHM_K + kws + 32 * 256) = S.st_k1; } while (0)
#define SWRITE_HV(bf) do { *(bf16x8*)(V_lds + (bf) * SHM_V + vst0) = S.st_v0; *(bf16x8*)(V_lds + (bf) * SHM_V + vst1) = S.st_v1; } while (0)
#define SWRITE_H(bf) do { SWRITE_HV(bf); SWRITE_HK(bf); } while (0)
__device__ __forceinline__ void prime(const BlockRef& cur, char* lds, Seam& S, const int wid) {
    const int lane = lane_id(), tid = wid * 64 + lane, r32 = lane & 31, hi = lane >> 5;
    const int sr = tid >> 4, sc = (tid & 15) * 8, kws = KSWZ(sr, sc * 2); char* K_lds = lds + 2 * SHM_V;
    const int kb0 = cur.jlo * KVBLK;
#pragma unroll
    for (int d0 = 0; d0 < 8; ++d0) S.qr[d0] = LD8((const char*)(cur.Q + (size_t)(wid * QBLK) * NP) + (unsigned)((r32 * NP + hi * 8) * 2) + d0 * 32);
    const unsigned roff = (unsigned)(sr * cur.pkv + sc) * 2u;
    SLOAD_H(cur.K, cur.K + cur.voff, cur.pkv, kb0, roff); VMW(); SWRITE_HK(0);
    __syncthreads();
}
__device__ __forceinline__ void block(const BlockRef& cur, const BlockRef& nxt, char* lds, Seam& S, const int wid) {
    const int lane = lane_id(), tid = wid * 64 + lane, r32 = lane & 31, hi = lane >> 5;
    const int j_lo = cur.jlo;
    int j_hi = (cur.P0 + QB - 1) / KVBLK + 1; if (j_hi > cur.skv / KVBLK) j_hi = cur.skv / KVBLK;
    const int NT = j_hi - j_lo;
    const int kbn = nxt.jlo * KVBLK;
    const int qlo = cur.P0 + wid * QBLK, qm = qlo + r32 - 4 * hi;
    char* V_lds = lds; char* K_lds = lds + 2 * SHM_V;
    float* ws = (float*)(lds + 2 * SHM_V + 2 * SHM_K) + wid * 64; float* li_l = ws, * al_l = ws + 32;
    float* c_l = (float*)(lds + LDS_C);
#ifdef ATT_NO_BIAS
    if (0)
#endif
    {   const int n = j_hi * KVBLK; const float* Cg = cur.C; const float c0 = Cg[cur.c0i];
#pragma unroll 1
#ifdef ATT_BIAS_NOFILL
        for (int i = j_lo * KVBLK + tid; i < n; i += 512) c_l[i] = c0 * 0.f;
#else
        for (int i = j_lo * KVBLK + tid; i < n; i += 512) c_l[i] = (Cg[i] - c0) * (1.f / SCALE);
#endif
        __syncthreads(); }
#ifdef ATT_NO_BIAS
    const float cq = 0.f;
#else
    const float cq = c_l[cur.c0i + wid * QBLK + r32];
#endif
    float m_reg = -1e30f, l_reg = 0; f32x16 o[4] = {};
    const int sr = tid >> 4, sc = (tid & 15) * 8, vst0 = v_st(sr, sc), vst1 = v_st(32 + sr, sc), kws = KSWZ(sr, sc * 2);
    const int vb0 = (int)(uintptr_t)V_lds + v_rd_base(lane);
    const bf16_t* Kh = cur.K; const bf16_t* Vh = cur.K + cur.voff; const int pkv = cur.pkv; const unsigned roff = (unsigned)(sr * pkv + sc) * 2u;
#define RESC(a) do { if (__any((a) < 1.f)) { if (hi == 0) al_l[r32] = (a); asm volatile("s_waitcnt lgkmcnt(0)" ::: "memory");              \
                     for (int d_ = 0; d_ < 4; ++d_) for (int r = 0; r < 16; ++r) o[d_][r] *= al_l[crow(r, hi)]; } } while (0)
#define KBASE(t) ((j_lo + (t)) * KVBLK)
#define MASKT(P0_, P1_, t) do { const int kb_ = KBASE(t); if (kb_ + KVBLK - 1 > qlo) mask_tile(P0_, P1_, qm - kb_, WBIG); } while (0)
#define QKT(KB, P0_, P1_, t) qkt<KB>(P0_, P1_, K_lds, r32, hi, S.qr, c_l + KBASE(t) + 4 * hi, cq)
    constexpr int NQL = 8;
#define SEAM_K0() do { VMWN(NQL); SWRITE_HK(0); SBAR(); } while (0)
    f32x16 pA0, pA1, pB0, pB1; float mnA, mnB, alA, alB; bf16x8 pa0, pa1, pa2, pa3;
    SWRITE_HV(0); SBAR();
    if (NT > 1) { SLOAD_H(Kh, Vh, pkv, KBASE(1), roff); }
    SBAR(); QKT(0, pA0, pA1, 0);
    MASKT(pA0, pA1, 0); partialSM(pA0, pA1, m_reg, mnA, alA);
    if (NT > 1) { VMW(); SWRITE_H(1); }
    __syncthreads();
#define HALF_STEP(PX0, PX1, mnX, alX, PY0, PY1, alY, t, KB, VB, SB) do {                                                      \
        SBAR(); QKT(KB, PX0, PX1, t);                                                                                         \
        finishSM(PY0, PY1, alY, l_reg, pa0, pa1, pa2, pa3); SBAR();                                                           \
        if ((t) + 1 < NT) { SLOAD_H(Kh, Vh, pkv, KBASE((t) + 1), roff); SBAR(); }                                                   \
        pv_tile<VB>(o, vb0, pa0, pa1, pa2, pa3); MASKT(PX0, PX1, (t)); partialSM(PX0, PX1, m_reg, mnX, alX);                  \
        __syncthreads();                                                                                                      \
        if ((t) + 1 < NT) { VMW(); SWRITE_H(SB); }                                                                            \
        RESC(alX); __syncthreads(); } while (0)
    for (int t = 1; t + 1 < NT; t += 2) {
        HALF_STEP(pB0, pB1, mnB, alB, pA0, pA1, alA, t, 1, 0, 0);
        HALF_STEP(pA0, pA1, mnA, alA, pB0, pB1, alB, t + 1, 0, 1, 1);
    }
    const bool even = (NT & 1) == 0;
    if (even) { SBAR(); QKT(1, pB0, pB1, NT - 1); SBAR(); }
    { const unsigned roffn = (unsigned)(sr * nxt.pkv + sc) * 2u; SLOAD_H(nxt.K, nxt.K + nxt.voff, nxt.pkv, kbn, roffn); } SBAR();
#pragma unroll
    for (int d0 = 0; d0 < 8; ++d0) S.qr[d0] = LD8((const char*)(nxt.Q + (size_t)(wid * QBLK) * NP) + (unsigned)((r32 * NP + hi * 8) * 2) + d0 * 32);
    SBAR();
    finishSM(pA0, pA1, alA, l_reg, pa0, pa1, pa2, pa3); SBAR();
    pv_tile<0>(o, vb0, pa0, pa1, pa2, pa3);
    if (even) { MASKT(pB0, pB1, NT - 1); partialSM(pB0, pB1, m_reg, mnB, alB); __syncthreads(); RESC(alB);
        finishSM(pB0, pB1, alB, l_reg, pa0, pa1, pa2, pa3); SBAR(); pv_tile<1>(o, vb0, pa0, pa1, pa2, pa3); }
    SBAR(); SEAM_K0();
    int lane_e = lane; asm volatile("" : "+v"(lane_e));
    const int r32e = lane_e & 31, hie = lane_e >> 5;
    if (hie == 0) li_l[r32e] = l_reg; asm volatile("s_waitcnt lgkmcnt(0)" ::: "memory");
    float rli[16];
#pragma unroll
    for (int r = 0; r < 16; ++r) rli[r] = __builtin_amdgcn_rcpf(li_l[crow(r, hie)]);
    __syncthreads();
#ifndef ATT_NO_EPI
    bf16x8 gt[8];
    { const bf16_t* Gw = cur.Q + cur.goff + (size_t)(wid * QBLK + (lane_e >> 4)) * NP + (lane_e & 15) * 8;
#pragma unroll
      for (int i = 0; i < 8; ++i) gt[i] = LD8(Gw + (size_t)(i * 4) * NP); }
    SBAR();
    char* stg = lds + LDS_C + wid * 8704;
#pragma unroll
    for (int r = 0; r < 16; ++r) { const int orow = crow(r, hie);
#pragma unroll
        for (int d0 = 0; d0 < 4; ++d0) *(bf16_t*)(stg + orow * 272 + (d0 * 32 + r32e) * 2) = (bf16_t)f2bf(o[d0][r] * rli[r]); }
    asm volatile("s_waitcnt lgkmcnt(0)" ::: "memory");
    { bf16_t* Ow = cur.O + (size_t)(wid * QBLK + (lane_e >> 4)) * DM + (lane_e & 15) * 8;
#pragma unroll
      for (int i = 0; i < 8; ++i) { const bf16x8 ov = *(const bf16x8*)(stg + (i * 4 + (lane_e >> 4)) * 272 + (lane_e & 15) * 16); float v[8];
#pragma unroll
          for (int e = 0; e < 8; ++e) { const float g = bf2f((unsigned short)gt[i][e]); v[e] = bf2f((unsigned short)ov[e]) * g * sigmoidf_(g); }
          u32x4 w = {cvtpk(v[0], v[1]), cvtpk(v[2], v[3]), cvtpk(v[4], v[5]), cvtpk(v[6], v[7])};
          *(u32x4*)(Ow + (size_t)(i * 4) * DM) = w; } }
#endif
    __syncthreads();
#undef RESC
#undef KBASE
#undef MASKT
#undef QKT
#undef SEAM_K0
#undef HALF_STEP
}
#undef VMW
#undef VMWN
#undef SLOAD_H
#undef SWRITE_HK
#undef SWRITE_HV
#undef SWRITE_H
}

__device__ __forceinline__ bool get_attn(int b, int n, unsigned char* ws, att::BlockRef& r) {
    const bf16_t* P = (const bf16_t*)(ws + WS_P); bf16_t* Y = (bf16_t*)(ws + WS_Y);
    if (n == 0) {
        const int h = b & 7, qb = 31 - (b >> 3);
        r.Q = P + (size_t)(qb * 256) * NP + C_FQ + h * 128; r.K = P + C_FK + h * 128; r.voff = C_FV - C_FK; r.goff = C_FG - C_FQ;
        r.C = (const float*)(ws + WS_CS) + h * SEQ; r.O = Y + (size_t)(qb * 256) * DM + Y_FOX + h * 128; r.P0 = qb * 256; r.skv = SEQ; r.pkv = NP; r.jlo = 0; r.c0i = qb * 256; return true; }
    if (n == 1 && b >= 128) {
        const int m = 255 - b, h = m & 3, qb = m >> 2; const bf16_t* MKV = (const bf16_t*)(ws + WS_MKV);
        r.Q = P + (size_t)(qb * 256) * NP + C_MQ + h * 128; r.K = MKV + h * 128; r.voff = 512; r.goff = C_MG - C_MQ;
        r.C = (const float*)(ws + WS_SS); r.O = Y + (size_t)(qb * 256) * DM + Y_MEM + h * 128; r.P0 = 1 << 20; r.skv = MEMLEN; r.pkv = 1024; r.jlo = 0; r.c0i = 0; return true; }
    return false;
}

__device__ __forceinline__ void conv_item(int t0, const bf16_t* P, const float* conv_w, const float* conv_b, const float* ln_g, const float* ln_b,
                                          const bf16_t* WpwT, bf16_t* Y, char* lds, const int wid) {
    const int lane = lane_id(), tid = wid * 64 + lane;
    float* U = (float*)lds; float* red = (float*)(lds + 126976); float* stat = (float*)(lds + 129024); bf16_t* At = (bf16_t*)lds;
#pragma unroll
    for (int i = 0; i < 8; ++i) { const int idx = tid + i * 512, r = idx >> 6, ch = (idx & 63) * 8;
        if (r < 62) { const int tok = t0 - 30 + r; f32x4 u0 = {0.f, 0.f, 0.f, 0.f}, u1 = u0;
            if (tok >= 0) { const bf16x8 a = LD8(P + (size_t)tok * NP + C_CVA + ch), b = LD8(P + (size_t)tok * NP + C_CVB + ch);
#pragma unroll
                for (int e = 0; e < 4; ++e) { u0[e] = bf2f((unsigned short)a[e]) * sigmoidf_(bf2f((unsigned short)b[e])); u1[e] = bf2f((unsigned short)a[4 + e]) * sigmoidf_(bf2f((unsigned short)b[4 + e])); } }
            *(f32x4*)(U + r * 512 + ch) = u0; *(f32x4*)(U + r * 512 + ch + 4) = u1; } }
    __syncthreads();
    const int c = tid;
    float w[31];
#pragma unroll
    for (int k = 0; k < 31; ++k) w[k] = conv_w[k * 512 + c];
    float acc[32]; { const float bias = conv_b[c];
#pragma unroll
        for (int t = 0; t < 32; ++t) acc[t] = bias; }
#pragma unroll
    for (int r = 0; r < 62; ++r) { const float uv = U[r * 512 + c];
#pragma unroll
        for (int t = 0; t < 32; ++t) { if (r - t >= 0 && r - t <= 30) acc[t] = fmaf(w[r - t], uv, acc[t]); } }
#pragma unroll
    for (int t = 0; t < 32; ++t) { float s1 = acc[t], s2 = acc[t] * acc[t];
#pragma unroll
        for (int o = 1; o < 64; o <<= 1) { s1 += __shfl_xor(s1, o); s2 += __shfl_xor(s2, o); }
        if (lane == 0) { red[(wid * 32 + t) * 2] = s1; red[(wid * 32 + t) * 2 + 1] = s2; } }
    __syncthreads();
    if (tid < 32) { float s1 = 0.f, s2 = 0.f;
#pragma unroll
        for (int wv = 0; wv < 8; ++wv) { s1 += red[(wv * 32 + tid) * 2]; s2 += red[(wv * 32 + tid) * 2 + 1]; }
        const float mean = s1 * (1.f / 512.f), var = s2 * (1.f / 512.f) - mean * mean; stat[tid * 2] = mean; stat[tid * 2 + 1] = rsqrtf(fmaxf(var, 0.f) + EPS); }
    __syncthreads();
    { const float g = ln_g[c], be = ln_b[c];
#pragma unroll
        for (int t = 0; t < 32; ++t) { const float y = (acc[t] - stat[2 * t]) * stat[2 * t + 1] * g + be; At[t * 520 + c] = (bf16_t)f2bf(y * sigmoidf_(y)); } }
    __syncthreads();
    const int r32 = lane & 31, hi = lane >> 5, nb = wid * 64;
    f32x16 o0 = {}, o1 = {};
    const bf16_t* w0p = WpwT + (size_t)(nb + r32) * 512 + hi * 8; const bf16_t* w1p = w0p + 32 * 512; const bf16_t* ap = At + r32 * 520 + hi * 8;
#pragma unroll 4
    for (int ks = 0; ks < 32; ++ks) { const bf16x8 zf = LD8(ap + ks * 16), wa = LD8(w0p + ks * 16), wb = LD8(w1p + ks * 16);
        o0 = __builtin_amdgcn_mfma_f32_32x32x16_bf16(wa, zf, o0, 0, 0, 0); o1 = __builtin_amdgcn_mfma_f32_32x32x16_bf16(wb, zf, o1, 0, 0, 0); }
    { const int tok = t0 + r32;
#pragma unroll
        for (int blk = 0; blk < 2; ++blk)
#pragma unroll
            for (int g4 = 0; g4 < 4; ++g4) { const int n = nb + blk * 32 + 8 * g4 + 4 * hi; const s16x4 gt = *(const s16x4*)(P + (size_t)tok * NP + C_CVG + n);
                float v[4];
#pragma unroll
                for (int j = 0; j < 4; ++j) { const float gv = bf2f((unsigned short)gt[j]); v[j] = (blk ? o1[4 * g4 + j] : o0[4 * g4 + j]) * gv * sigmoidf_(gv); }
                u32x2 pk; pk.x = pk2(v[0], v[1]); pk.y = pk2(v[2], v[3]); *(u32x2*)(Y + (size_t)tok * DM + Y_CONV + n) = pk; } }
    __syncthreads();
}

__device__ __forceinline__ void transpose_item(const float* W, int srcN, int K, int ncols, int shift_from, bf16_t* WT, float* scr, int item, int lane) {
    const int nblk = ncols / 32, kb = item / nblk, nb = item % nblk, k0 = 64 * kb, n0 = 32 * nb, sn0 = n0 + (n0 >= shift_from ? 8 : 0);
#pragma unroll 8
    for (int i = 0; i < 32; ++i) { const int kk = 2 * i + (lane >> 5); scr[kk * 33 + (lane & 31)] = W[(size_t)(k0 + kk) * srcN + sn0 + (lane & 31)]; }
    asm volatile("s_waitcnt lgkmcnt(0)" ::: "memory");
    const int c = lane & 7;
#pragma unroll
    for (int j = 0; j < 4; ++j) { const int n = (lane >> 3) + 8 * j; const float* s = scr + (8 * c) * 33 + n;
        u32x4 o; o.x = pk2(s[0 * 33], s[1 * 33]); o.y = pk2(s[2 * 33], s[3 * 33]); o.z = pk2(s[4 * 33], s[5 * 33]); o.w = pk2(s[6 * 33], s[7 * 33]);
        *(u32x4*)(WT + (size_t)(n0 + n) * K + k0 + 8 * c) = o; }
    asm volatile("s_waitcnt lgkmcnt(0)" ::: "memory");
}
__device__ __forceinline__ void norm_row(const float* xrow, const float* gvec, bf16_t* orow, int lane, const float* wf_lds, const float* b_f, float* logf_out  ) {
    const f32x4* xr = (const f32x4*)xrow + lane; const f32x4* gr = (const f32x4*)gvec + lane;
    f32x4 v[8]; float s = 0.f;
#pragma unroll
    for (int j = 0; j < 8; ++j) { v[j] = xr[64 * j]; s += (v[j].x * v[j].x + v[j].y * v[j].y) + (v[j].z * v[j].z + v[j].w * v[j].w); }
    const float rstd = rsqrtf(wave_sum(s) * (1.f / DM) + EPS);
#pragma unroll
    for (int j = 0; j < 8; ++j) v[j] = v[j] * rstd * gr[64 * j];
    unsigned long long* o8 = (unsigned long long*)orow + lane;
#pragma unroll
    for (int j = 0; j < 8; ++j) o8[64 * j] = (unsigned long long)pk2(v[j].x, v[j].y) | ((unsigned long long)pk2(v[j].z, v[j].w) << 32);
    if (wf_lds) {
        f32x4 f0 = {0.f, 0.f, 0.f, 0.f}, f1 = f0; const f32x4* wf = (const f32x4*)wf_lds + 8 * lane;
#pragma unroll 1
        for (int j = 0; j < 8; ++j) { const f32x4 hv = xr[64 * j] * gr[64 * j]; const f32x4* wj = wf + 512 * j;
#pragma unroll
            for (int i = 0; i < 4; ++i) { f0 += hv[i] * wj[2 * i]; f1 += hv[i] * wj[2 * i + 1]; } }
        f0 = f0 * rstd; f1 = f1 * rstd;
        float f[8] = {f0[0], f0[1], f0[2], f0[3], f1[0], f1[1], f1[2], f1[3]};
#pragma unroll
        for (int h = 0; h < 8; ++h) { const float z = wave_sum(f[h]) + b_f[h]; const float ls = fminf(z, 0.f) - log1pf(__expf(-fabsf(z))); if (lane == h) logf_out[(size_t)h * SEQ] = ls; }
    }
}

__device__ __forceinline__ const void* lds_ptr(const unsigned char* lds, int k) {
    const unsigned lo = *(const volatile unsigned*)(lds + 146944 + 8 * k), hi = *(const volatile unsigned*)(lds + 146944 + 8 * k + 4);
    return (const void*)(((unsigned long long)(unsigned)__builtin_amdgcn_readfirstlane((int)hi) << 32) | (unsigned)__builtin_amdgcn_readfirstlane((int)lo));
}
__device__ __forceinline__ void grid_bar(unsigned* ctr, unsigned target, int wave) {
    __threadfence();
    __syncthreads();
    if (wave == 0 && lane_id() == 0) {
        __hip_atomic_fetch_add(ctr, 1u, __ATOMIC_RELEASE, __HIP_MEMORY_SCOPE_AGENT);
        while (__hip_atomic_load(ctr, __ATOMIC_ACQUIRE, __HIP_MEMORY_SCOPE_AGENT) < target) __builtin_amdgcn_s_sleep(2);
    }
    __syncthreads();
    __threadfence();
}
struct Args { const float* in[14]; float* out; unsigned char* ws; int ph_lo, ph_hi; };
__global__ void __launch_bounds__(512, 2) fwd_kernel(Args a) {
    extern __shared__ __attribute__((aligned(16))) unsigned char lds[];
    if (a.ph_hi > 1000) { cg::grid_group grid = cg::this_grid(); grid.sync(); }
    const int wave = __builtin_amdgcn_readfirstlane((int)(threadIdx.x >> 6));
#define lane lane_id()
#define tid (wave * 64 + lane_id())
    const int G = gridDim.x, b = blockIdx.x;
    unsigned char* ws = a.ws;
    if (threadIdx.x < 14) ((const float**)(lds + 146944))[threadIdx.x] = a.in[threadIdx.x];
    __syncthreads();
#define ARGP(k) ((const float*)lds_ptr(lds, (k)))
    const int lo = a.ph_lo, hi = a.ph_hi;
#define IN(k) (lo <= (k) && (k) < hi)
#define BOTH(k) (IN(k) && IN((k) + 1))

#ifndef SKIP_P0
    if (IN(0)) {
        const float* x = ARGP(0); const float* mem = ARGP(1); const float* norm_g = ARGP(2); const float* mem_norm_g = ARGP(3); const float* w_in = ARGP(4); const float* b_f = ARGP(5);
        const float* w_conv_pw = ARGP(10); const float* w_mem_kv = ARGP(11); const float* w_out = ARGP(12);
        float* ss = (float*)(ws + WS_SS);
        for (int i = b * 512 + tid; i < SEQ; i += G * 512) ss[i] = 0.f;
        float* wf = (float*)(lds + 73728);
        for (int idx = tid; idx < 4096; idx += 512) { const int k = idx >> 1, half = idx & 1; *(f32x4*)(wf + k * 8 + half * 4) = *(const f32x4*)(w_in + (size_t)k * DIN + FCOL + half * 4); }
        __syncthreads();
        const int gw = b * 8 + wave, NGW = G * 8;
        bf16_t* XB = (bf16_t*)(ws + WS_A); bf16_t* MEMN = (bf16_t*)(ws + WS_MEMN); float* LOGF = (float*)(ws + WS_LOGF);
#ifndef SKIP_ROWS
        for (int m = gw; m < SEQ; m += NGW) norm_row(x + (size_t)m * DM, norm_g, XB + (size_t)m * DM, lane, wf, b_f, LOGF + m);
        for (int m = gw; m < MEMLEN; m += NGW) norm_row(mem + (size_t)m * DM, mem_norm_g, MEMN + (size_t)m * DM, lane, nullptr, nullptr, nullptr);
#endif
#ifndef SKIP_TR
        float* scr = (float*)(lds + wave * 8448);
        constexpr int I_IN = 32 * (NP / 32), I_KV = 32 * 32, I_OUT = 32 * 64, I_PW = 8 * 16, NITEMS = I_IN + I_KV + I_OUT + I_PW;
        for (int it = gw; it < NITEMS; it += NGW) {
            int r = it;
            if (r < I_IN) { transpose_item(w_in, DIN, DM, NP, FCOL, (bf16_t*)(ws + WS_B), scr, r, lane); continue; } r -= I_IN;
            if (r < I_KV) { transpose_item(w_mem_kv, 1024, DM, 1024, 1 << 30, (bf16_t*)(ws + WS_WKV), scr, r, lane); continue; } r -= I_KV;
            if (r < I_OUT) { transpose_item(w_out, DM, DM, DM, 1 << 30, (bf16_t*)(ws + WS_WOUT), scr, r, lane); continue; } r -= I_OUT;
            transpose_item(w_conv_pw, 512, 512, 512, 1 << 30, (bf16_t*)(ws + WS_WPW), scr, r, lane);
        }
#endif
    }
#endif
    if (BOTH(0)) grid_bar((unsigned*)(ws + WS_BAR), (unsigned)(1 * G), wave);

#ifndef SKIP_P1
    if (IN(1)) {
        if (b < 8) {
            const float* lf = (const float*)(ws + WS_LOGF) + (size_t)b * SEQ; float* cs = (float*)(ws + WS_CS) + (size_t)b * SEQ; float* wt = (float*)lds;
            f32x4 v[4]; float run = 0.f;
#pragma unroll
            for (int j = 0; j < 4; ++j) { v[j] = *(const f32x4*)(lf + tid * 16 + j * 4);
                v[j].x += run; v[j].y += v[j].x; v[j].z += v[j].y; v[j].w += v[j].z; run = v[j].w; }
            float inc = run;
#pragma unroll
            for (int o = 1; o < 64; o <<= 1) { const float t = __shfl_up(inc, o); if (lane >= o) inc += t; }
            if (lane == 63) wt[wave] = inc;
            __syncthreads();
            float off = inc - run;
            for (int wv = 0; wv < wave; ++wv) off += wt[wv];
#pragma unroll
            for (int j = 0; j < 4; ++j) *(f32x4*)(cs + tid * 16 + j * 4) = v[j] + off;
            __syncthreads();
        }
        pg8::Gemm g{(const pg8::bf16_t*)(ws + WS_A), (const pg8::bf16_t*)(ws + WS_B), SEQ + 256, NP + 1024, DM};
        Sched1 S{G, b}; Epi1 E{(bf16_t*)(ws + WS_P), (bf16_t*)(ws + WS_MKV)};
        pg8::gemm_phase<Epi1, Sched1, true, true>((LAS unsigned char*)lds, g, S, E, wave);
    }
#endif
    if (BOTH(1)) grid_bar((unsigned*)(ws + WS_BAR), (unsigned)(2 * G), wave);

#ifndef SKIP_P2
    if (IN(2)) {
#ifndef SKIP_ATT
        att::Seam S; att::BlockRef cur, nxt; int n = 0;
        if (get_attn(b, 0, ws, cur)) {
            att::prime(cur, (char*)lds, S, wave);
            for (;;) { const bool more = get_attn(b, n + 1, ws, nxt); if (!more) nxt = cur;
                att::block(cur, nxt, (char*)lds, S, wave);
                if (!more) break; cur = nxt; ++n; }
        }
        asm volatile("s_waitcnt vmcnt(0)" ::: "memory");
        __syncthreads();
#endif
#ifndef SKIP_CONV
        const float* conv_w = ARGP(6); const float* conv_b = ARGP(7); const float* conv_ln_g = ARGP(8); const float* conv_ln_b = ARGP(9);
        for (int cv = 0; cv < 256; ++cv) if (255 - (cv >> 1) == b)
            conv_item(cv * 32, (const bf16_t*)(ws + WS_P), conv_w, conv_b, conv_ln_g, conv_ln_b, (const bf16_t*)(ws + WS_WPW), (bf16_t*)(ws + WS_Y), (char*)lds, wave);
#endif
    }
#endif
    if (BOTH(2)) grid_bar((unsigned*)(ws + WS_BAR), (unsigned)(3 * G), wave);

#ifndef SKIP_P3
    if (IN(3)) {
        pg8::Gemm g{(const pg8::bf16_t*)(ws + WS_Y), (const pg8::bf16_t*)(ws + WS_WOUT), SEQ, DM, DM};
        pg8::StaticOrder S; S.init(SEQ, DM, G, b); Epi2 E{ARGP(0), a.out, (float*)(ws + WS_SS)};
        pg8::gemm_phase<Epi2, pg8::StaticOrder, true, true>((LAS unsigned char*)lds, g, S, E, wave);
    }
#endif
    if (BOTH(3)) grid_bar((unsigned*)(ws + WS_BAR), (unsigned)(4 * G), wave);

#ifndef SKIP_P4
    if (IN(4)) {
        const float* ss = (const float*)(ws + WS_SS); const int gw = b * 8 + wave, NGW = G * 8;
        for (int m = gw; m < SEQ; m += NGW) { const float sc = rsqrtf(ss[m] * (1.f / DM) + EPS);
            f32x4* o = (f32x4*)(a.out + (size_t)m * DM) + lane; const f32x4* gr = (const f32x4*)ARGP(13) + lane;
#pragma unroll
            for (int j = 0; j < 8; ++j) o[64 * j] = o[64 * j] * sc * gr[64 * j]; }
    }
#endif
#undef IN
#undef BOTH
#undef lane
#undef tid
}

#ifndef PH_LO
#define PH_LO 0
#endif
#ifndef PH_HI
#define PH_HI 5
#endif
#ifndef N_LAUNCHES
#define N_LAUNCHES 1
#endif
extern "C" void kernel_launch(void* const* d_in, const int* in_sizes, int n_in, void* d_out, int out_size, void* d_ws, size_t ws_size, hipStream_t stream) {
    static int grid = 0;
    if (grid == 0) {
        if (n_in != 14 || out_size != SEQ * DM || ws_size < WS_END) { fprintf(stderr, "kernel_launch: unexpected shapes (n_in %d out %d ws %zu)\n", n_in, out_size, ws_size); grid = -1; return; }
        int dev = 0, cus = 0, per_cu = 0;
        (void)hipGetDevice(&dev); (void)hipDeviceGetAttribute(&cus, hipDeviceAttributeMultiprocessorCount, dev);
        if (hipFuncSetAttribute((const void*)fwd_kernel, hipFuncAttributeMaxDynamicSharedMemorySize, LDS_BYTES) != hipSuccess) { fprintf(stderr, "kernel_launch: hipFuncSetAttribute failed\n"); grid = -1; return; }
        if (hipOccupancyMaxActiveBlocksPerMultiprocessor(&per_cu, (const void*)fwd_kernel, 512, LDS_BYTES) != hipSuccess || per_cu < 1) per_cu = 1;
        (void)hipGetLastError();
        if (cus <= 0) cus = 256;
        grid = cus * per_cu; if (grid > 256) grid = 256;
        if (grid != 256) { fprintf(stderr, "kernel_launch: this kernel needs a 256-workgroup cooperative grid (got %d)\n", grid); grid = -1; return; }
    }
    if (grid < 0) return;
    if (hipMemsetAsync((char*)d_ws + WS_BAR, 0, 256, stream) != hipSuccess) { fprintf(stderr, "kernel_launch: memset failed\n"); return; }
    Args a{};
    for (int i = 0; i < 14; ++i) a.in[i] = (const float*)d_in[i];
    a.out = (float*)d_out; a.ws = (unsigned char*)d_ws;
    for (int li = 0; li < N_LAUNCHES; ++li) {
        if (N_LAUNCHES == 1) { a.ph_lo = PH_LO; a.ph_hi = PH_HI; } else { a.ph_lo = li; a.ph_hi = li + 1; }
        void* args[] = {&a};
        hipError_t e = hipLaunchCooperativeKernel((const void*)fwd_kernel, dim3(grid), dim3(512), args, LDS_BYTES, stream);
        if (e != hipSuccess) { fprintf(stderr, "kernel_launch: cooperative launch failed: %s (grid %d)\n", hipGetErrorString(e), grid); break; }
    }
}
```

```cpp
#include <hip/hip_runtime.h>
#include <hip/hip_cooperative_groups.h>
#include <cstdio>
#include <cstdint>
namespace cg = cooperative_groups;

namespace pg8 {
#define PG8_LAS __attribute__((address_space(3)))
typedef unsigned short bf16_t;
typedef short bf16x8 __attribute__((ext_vector_type(8)));
typedef float f32x4 __attribute__((ext_vector_type(4)));
typedef unsigned u32x4 __attribute__((ext_vector_type(4)));
constexpr int BM = 256, BK = 64, HALF = 128, HTB = HALF * BK * 2  , STAGE_BYTES = 8 * HTB, NXCD = 8, WGM = 8;

__host__ __device__ __forceinline__ int lds_byte(int r, int c) { const int st = (r >> 4) * 2 + (c >> 5), rr = r & 15, cc = c & 31, ob = rr * 64 + cc * 2; return st * 1024 + (ob ^ (((ob >> 9) & 1) << 5)); }
__host__ __device__ __forceinline__ void stage_rc(int b, int& R, int& C) { const int st = b / 1024, sb = b % 1024, swz = sb ^ (((sb >> 9) & 1) << 5); R = (st >> 1) * 16 + swz / 64; C = (st & 1) * 32 + (swz % 64) / 2; }
__host__ __device__ __forceinline__ int perm32(int rho) { const int n = rho >> 4, i = rho & 15; return 8 * (i >> 2) + 4 * n + (i & 3); }

struct Unit { int pm, pn; };
struct Gemm { const bf16_t* A; const bf16_t* Bt; int M, N, K; };

struct StaticOrder {
    int nM, nN, nwg, G, c;
    __host__ __device__ void init(int M, int N, int G_, int c_) { nM = M / BM; nN = N / BM; nwg = nM * nN; G = G_; c = c_; }
    __host__ __device__ bool next(int i, Unit& u) const {
        const long L = (long)i * G + c; if (L >= nwg) return false;
        int wgid = (int)L; { const int q = nwg / NXCD, r = nwg % NXCD, xcd = wgid % NXCD, off = wgid / NXCD; wgid = (xcd < r ? xcd * (q + 1) : r * (q + 1) + (xcd - r) * q) + off; }
        const int nig = WGM * nN, gid = wgid / nig, fm = gid * WGM, gsz = (nM - fm) < WGM ? (nM - fm) : WGM;
        u.pm = fm + ((wgid % nig) % gsz); u.pn = (wgid % nig) / gsz; return true;
    }
    __device__ __forceinline__ void a_ready(const Unit&) const {}
    __device__ __forceinline__ void done(const Unit&) const {}
};

__device__ __forceinline__ unsigned cvt_pk_bf16(float lo, float hi) { unsigned r; asm volatile("v_cvt_pk_bf16_f32 %0, %1, %2" : "=v"(r) : "v"(lo), "v"(hi)); return r; }
typedef float f32x2 __attribute__((ext_vector_type(2)));
template <class Epi, class Sched, bool ALIGN_EPI = false, bool SP2 = false, bool HALF_M = false>
__device__ __forceinline__ void gemm_phase(PG8_LAS unsigned char* lds, const Gemm g, const Sched& S, const Epi& E, const int wv_) {
    const int wid = wv_, lane = (int)__builtin_amdgcn_mbcnt_hi(~0u, __builtin_amdgcn_mbcnt_lo(~0u, 0u)), tid = wid * 64 + lane, wr = wid >> 2, wc = wid & 3, fr = lane & 15, fq = lane >> 4;
    const int K = g.K, nt = K / BK;
    unsigned voffA[2], voffB[2];
#pragma unroll
    for (int i = 0; i < 2; ++i) { int R, C; stage_rc(tid * 16 + i * 8192, R, C); const int Rb = Epi::PERM ? ((R & ~31) + perm32(R & 31)) : R;
        voffA[i] = (unsigned)(R * K + C) * 2u; voffB[i] = (unsigned)(Rb * K + C) * 2u; }
    const size_t kstep = (size_t)(BK * 2);
    const size_t hstep = (size_t)HALF * K * 2;
    const size_t tstep = 2 * hstep;
    const size_t tstepA = HALF_M ? hstep : tstep;
    const unsigned ldsw = (unsigned)wid * 1024u;
    const int aoff = lds_byte(wr * 64 + fr, fq * 8), boff = lds_byte(wc * 32 + fr, fq * 8);
#define PG8_SA(b, h) (((b) * 2 + (h)) * HTB)
#define PG8_SB(b, h) ((4 + (b) * 2 + (h)) * HTB)
#define PG8_STAGE(bufoff, gbase, voff) do { _Pragma("unroll") for (int _i = 0; _i < 2; ++_i) \
        __builtin_amdgcn_global_load_lds((const unsigned*)((const char*)(gbase) + (voff)[_i]), (PG8_LAS unsigned*)(lds + (bufoff) + ldsw + _i * 8192), 16, 0, 0); } while (0)
#define PG8_LDA(dst, b, h) do { _Pragma("unroll") for (int m = 0; m < 4; ++m) _Pragma("unroll") for (int k = 0; k < 2; ++k) dst[m][k] = *(const PG8_LAS bf16x8*)(lds + PG8_SA(b, h) + aoff + m * 2048 + k * 1024); } while (0)
#define PG8_LDB(dst, b, h) do { _Pragma("unroll") for (int n = 0; n < 2; ++n) _Pragma("unroll") for (int k = 0; k < 2; ++k) dst[n][k] = *(const PG8_LAS bf16x8*)(lds + PG8_SB(b, h) + boff + n * 2048 + k * 1024); } while (0)
#define PG8_MMA(ai, bj, At, Bt) do { __builtin_amdgcn_s_setprio(1); _Pragma("unroll") for (int m = 0; m < 4; ++m) _Pragma("unroll") for (int n = 0; n < 2; ++n) _Pragma("unroll") for (int k = 0; k < 2; ++k) \
        acc[ai][bj][m][n] = __builtin_amdgcn_mfma_f32_16x16x32_bf16(Bt[n][k], At[m][k], acc[ai][bj][m][n], 0, 0, 0); __builtin_amdgcn_s_setprio(0); } while (0)
#define PG8_WAIT_V(n) asm volatile("s_waitcnt vmcnt(" #n ")" ::: "memory")
#define PG8_WAIT_L(n) asm volatile("s_waitcnt lgkmcnt(" #n ")" ::: "memory")
#define PG8_BAR __builtin_amdgcn_s_barrier()
#define PG8_SCHED __builtin_amdgcn_sched_barrier(0)
    Unit cur, nxt; int ui = 0;
    if (!S.next(0, cur)) return;
    f32x4 acc[2][2][4][2];
#pragma unroll
    for (int a = 0; a < 2; ++a)
#pragma unroll
        for (int b = 0; b < 2; ++b)
#pragma unroll
            for (int m = 0; m < 4; ++m)
#pragma unroll
                for (int n = 0; n < 2; ++n) acc[a][b][m][n] = (f32x4){0.f, 0.f, 0.f, 0.f};
    bf16x8 At[4][2], B0[2][2], B1[2][2];
    const char* cA = (const char*)g.A + (size_t)cur.pm * tstepA; const char* cB = (const char*)g.Bt + (size_t)cur.pn * tstep;
    S.a_ready(cur);
    if constexpr (SP2) {
        PG8_STAGE(PG8_SB(0, 0), cB, voffB); PG8_STAGE(PG8_SB(0, 1), cB + hstep, voffB); PG8_STAGE(PG8_SA(0, 0), cA, voffA); PG8_STAGE(PG8_SA(0, 1), cA + hstep, voffA);
        if (wr == 1) PG8_BAR;
        PG8_WAIT_V(2); PG8_BAR;
        PG8_STAGE(PG8_SB(1, 0), cB + kstep, voffB); PG8_STAGE(PG8_SA(1, 0), cA + kstep, voffA); PG8_STAGE(PG8_SB(1, 1), cB + hstep + kstep, voffB);
        PG8_WAIT_V(6); PG8_BAR;
    } else {
        PG8_STAGE(PG8_SB(0, 0), cB, voffB); PG8_STAGE(PG8_SA(0, 0), cA, voffA); PG8_STAGE(PG8_SB(0, 1), cB + hstep, voffB); PG8_STAGE(PG8_SA(0, 1), cA + hstep, voffA);
        if (wr == 1) PG8_BAR;
        PG8_WAIT_V(4); PG8_BAR;
        PG8_STAGE(PG8_SB(1, 0), cB + kstep, voffB); PG8_STAGE(PG8_SA(1, 0), cA + kstep, voffA); PG8_STAGE(PG8_SB(1, 1), cB + hstep + kstep, voffB);
        PG8_WAIT_V(6); PG8_BAR;
    }
    for (;;) {
        const bool has_next = S.next(ui + 1, nxt);
        const char* nA = has_next ? (const char*)g.A + (size_t)nxt.pm * tstepA : cA; const char* nB = has_next ? (const char*)g.Bt + (size_t)nxt.pn * tstep : cB;
        for (int t = 0; t < nt; t += 2) {
            const bool last = (t == nt - 2);
            const char* a1 = cA + (size_t)(t + 1) * kstep;
            const char* a2 = last ? nA : cA + (size_t)(t + 2) * kstep; const char* b2 = last ? nB : cB + (size_t)(t + 2) * kstep;
            const char* a3 = a2 + kstep; const char* b3 = b2 + kstep;
            if (last && has_next) S.a_ready(nxt);
            if constexpr (SP2) {
            PG8_LDB(B0, 0, 0); PG8_LDB(B1, 0, 1); PG8_SCHED; PG8_LDA(At, 0, 0); PG8_STAGE(PG8_SA(1, 1), a1 + hstep, voffA);
            PG8_WAIT_V(8); PG8_WAIT_L(0); PG8_BAR; PG8_MMA(0, 0, At, B0); PG8_MMA(0, 1, At, B1); PG8_BAR; PG8_SCHED;
            PG8_LDA(At, 0, 1); PG8_STAGE(PG8_SB(0, 0), b2, voffB); PG8_STAGE(PG8_SB(0, 1), b2 + hstep, voffB); PG8_STAGE(PG8_SA(0, 0), a2, voffA);
            PG8_WAIT_V(8); PG8_WAIT_L(0); PG8_BAR; if constexpr (!HALF_M) { PG8_MMA(1, 0, At, B0); PG8_MMA(1, 1, At, B1); } PG8_BAR; PG8_SCHED;
            PG8_LDB(B0, 1, 0); PG8_LDB(B1, 1, 1); PG8_SCHED; PG8_LDA(At, 1, 0); PG8_STAGE(PG8_SA(0, 1), a2 + hstep, voffA);
            PG8_WAIT_V(8); PG8_WAIT_L(0); PG8_BAR; PG8_MMA(0, 0, At, B0); PG8_MMA(0, 1, At, B1); PG8_BAR; PG8_SCHED;
            PG8_LDA(At, 1, 1); PG8_STAGE(PG8_SB(1, 0), b3, voffB); PG8_STAGE(PG8_SB(1, 1), b3 + hstep, voffB); PG8_STAGE(PG8_SA(1, 0), a3, voffA);
            PG8_WAIT_V(8); PG8_WAIT_L(0); PG8_BAR; if constexpr (!HALF_M) { PG8_MMA(1, 0, At, B0); PG8_MMA(1, 1, At, B1); } PG8_BAR; PG8_SCHED;
            } else {
            PG8_LDB(B0, 0, 0); PG8_SCHED; PG8_LDA(At, 0, 0); PG8_STAGE(PG8_SA(1, 1), a1 + hstep, voffA);
            PG8_WAIT_L(8); PG8_BAR; PG8_WAIT_L(0); PG8_MMA(0, 0, At, B0); PG8_BAR; PG8_SCHED;
            PG8_LDB(B1, 0, 1); PG8_STAGE(PG8_SB(0, 0), b2, voffB);
            PG8_BAR; PG8_WAIT_L(0); PG8_MMA(0, 1, At, B1); PG8_BAR;
            PG8_LDA(At, 0, 1); PG8_STAGE(PG8_SA(0, 0), a2, voffA);
            PG8_BAR; PG8_WAIT_L(0); PG8_MMA(1, 0, At, B0); PG8_BAR; PG8_SCHED;
            PG8_STAGE(PG8_SB(0, 1), b2 + hstep, voffB);
            PG8_WAIT_V(6); PG8_BAR; PG8_MMA(1, 1, At, B1); PG8_BAR;
            PG8_LDB(B0, 1, 0); PG8_SCHED; PG8_LDA(At, 1, 0); PG8_STAGE(PG8_SA(0, 1), a2 + hstep, voffA);
            PG8_WAIT_L(8); PG8_BAR; PG8_WAIT_L(0); PG8_MMA(0, 0, At, B0); PG8_BAR; PG8_SCHED;
            PG8_LDB(B1, 1, 1); PG8_STAGE(PG8_SB(1, 0), b3, voffB);
            PG8_BAR; PG8_WAIT_L(0); PG8_MMA(0, 1, At, B1); PG8_BAR;
            PG8_LDA(At, 1, 1); PG8_STAGE(PG8_SA(1, 0), a3, voffA);
            PG8_BAR; PG8_WAIT_L(0); PG8_MMA(1, 0, At, B0); PG8_BAR; PG8_SCHED;
            PG8_STAGE(PG8_SB(1, 1), b3 + hstep, voffB);
            PG8_WAIT_V(6); PG8_BAR; PG8_MMA(1, 1, At, B1); PG8_BAR;
            }
        }
        if constexpr (ALIGN_EPI) { if (wr == 0) PG8_BAR; }
        if constexpr (!Epi::AFTER_DRAIN) { E(acc, cur, wr, wc, fr, fq); S.done(cur); }
        if (!has_next) break;
#pragma unroll
        for (int a = 0; a < 2; ++a)
#pragma unroll
            for (int b = 0; b < 2; ++b)
#pragma unroll
                for (int m = 0; m < 4; ++m)
#pragma unroll
                    for (int n = 0; n < 2; ++n) acc[a][b][m][n] = (f32x4){0.f, 0.f, 0.f, 0.f};
        cur = nxt; cA = nA; cB = nB; ++ui;
        if constexpr (ALIGN_EPI) { if (wr == 1) PG8_BAR; }
    }
    PG8_WAIT_V(0);
    if constexpr (!ALIGN_EPI) { if (wr == 0) PG8_BAR; }
    PG8_BAR;
    if constexpr (Epi::AFTER_DRAIN) { E.fused(acc, cur, wr, wc, fr, fq, lds, wid, lane); S.done(cur); }
#undef PG8_SA
#undef PG8_SB
#undef PG8_STAGE
#undef PG8_LDA
#undef PG8_LDB
#undef PG8_MMA
#undef PG8_WAIT_V
#undef PG8_WAIT_L
#undef PG8_BAR
#undef PG8_SCHED
}
}

#define LAS __attribute__((address_space(3)))
typedef unsigned short bf16_t;
typedef short bf16x8 __attribute__((ext_vector_type(8)));
typedef short s16x4 __attribute__((ext_vector_type(4)));
typedef float f32x4 __attribute__((ext_vector_type(4)));
typedef float f32x16 __attribute__((ext_vector_type(16)));
typedef unsigned u32x4 __attribute__((ext_vector_type(4)));
typedef unsigned u32x2 __attribute__((ext_vector_type(2)));

constexpr int SEQ = 8192, DM = 2048, DIN = 6664, NP = 6656, MEMLEN = 256, FCOL = 4608;
constexpr int C_CVA = 0, C_CVB = 512, C_CVG = 1024, C_FQ = 1536, C_FK = 2560, C_FV = 3584, C_FG = 4608, C_MQ = 5632, C_MG = 6144;
constexpr int Y_CONV = 0, Y_FOX = 512, Y_MEM = 1536;
constexpr float EPS = 1e-6f;
constexpr size_t MiB = 1u << 20;
constexpr size_t WS_BAR = 64 * 1024;
constexpr size_t WS_SS = 0, WS_LOGF = 1 * MiB, WS_CS = 1 * MiB + 256 * 1024, WS_QN2 = 1 * MiB + 512 * 1024, WS_KN2 = 1 * MiB + 768 * 1024;
constexpr size_t WS_A = 2 * MiB;
constexpr size_t WS_MEMN = WS_A + 32 * MiB;
constexpr size_t WS_B = 36 * MiB;
constexpr size_t WS_WKV = WS_B + 26 * MiB;
constexpr size_t WS_WOUT = 66 * MiB, WS_WPW = 74 * MiB, WS_MKV = 75 * MiB, WS_P = 76 * MiB, WS_Y = 180 * MiB, WS_KVH = 212 * MiB, WS_END = 244 * MiB;
constexpr int LDS_BYTES = 147456;

__device__ __forceinline__ unsigned pk2(float lo, float hi) { unsigned r; asm("v_cvt_pk_bf16_f32 %0, %1, %2" : "=v"(r) : "v"(lo), "v"(hi)); return r; }
__device__ __forceinline__ unsigned f2bf(float f) { return pk2(f, f) & 0xffffu; }
__device__ __forceinline__ float bf2f(unsigned short b) { return __builtin_bit_cast(float, (unsigned)b << 16); }
__device__ __forceinline__ float sigmoidf_(float x) { return __builtin_amdgcn_rcpf(1.f + __expf(-x)); }
__device__ __forceinline__ float wave_sum(float v) {
#define DPP_(x, ctrl, rm) __builtin_bit_cast(float, __builtin_amdgcn_update_dpp(0, __builtin_bit_cast(int, (x)), (ctrl), (rm), 0xF, false))
    v += DPP_(v, 0xB1, 0xF);
    v += DPP_(v, 0x4E, 0xF);
    v += DPP_(v, 0x141, 0xF);
    v += DPP_(v, 0x140, 0xF);
    v += DPP_(v, 0x142, 0xA);
    v += DPP_(v, 0x143, 0xC);
#undef DPP_
    return __builtin_bit_cast(float, __builtin_amdgcn_readlane(__builtin_bit_cast(int, v), 63));
}
#define LD8(p) (*reinterpret_cast<const bf16x8*>(p))
__device__ __forceinline__ int lane_id() { return (int)__builtin_amdgcn_mbcnt_hi(~0u, __builtin_amdgcn_mbcnt_lo(~0u, 0u)); }

struct Sched1 {
    int G, c, nr;
    __device__ __forceinline__ bool next(int i, pg8::Unit& u) const {
        if (i >= nr) return false;
        const int L = i * G + c; if (L >= 836) return false;
        if (L >= 832) { u.pm = 32; u.pn = 26 + (L - 832); return true; }
        constexpr int nM = 32, nN = 26, nwg = 832, NX = 8, WGM = 8;
        int wgid = L; { const int q = nwg / NX, r = nwg % NX, xcd = wgid % NX, off = wgid / NX; wgid = (xcd < r ? xcd * (q + 1) : r * (q + 1) + (xcd - r) * q) + off; }
        const int nig = WGM * nN, gid = wgid / nig, fm = gid * WGM, gsz = (nM - fm) < WGM ? (nM - fm) : WGM;
        u.pm = fm + ((wgid % nig) % gsz); u.pn = (wgid % nig) / gsz; return true;
    }
    __device__ __forceinline__ void a_ready(const pg8::Unit&) const {}
    __device__ __forceinline__ void done(const pg8::Unit&) const {}
};
struct Epi1 {
    static constexpr bool PERM = true, AFTER_DRAIN = false;
    bf16_t* P; bf16_t* MKV; float* QN2; bf16_t* KVH;
    __device__ __forceinline__ void operator()(const pg8::f32x4 (&acc)[2][2][4][2], const pg8::Unit& u, int wr, int wc, int fr, int fq) const {
        bf16_t* base; int ldc, colt, row0;
        size_t bjs = 128;
        if (u.pm == 32) { base = MKV; ldc = 1024; colt = (u.pn - 26) * 256; row0 = wr * 64 + fr; }
        else if (u.pn >= 10 && u.pn < 18) { base = KVH + (size_t)((u.pn - 10) * 2) * SEQ * 128; ldc = 128; colt = 0; row0 = u.pm * 256 + wr * 64 + fr; bjs = (size_t)SEQ * 128; }
        else { base = P; ldc = NP; colt = u.pn * 256; row0 = u.pm * 256 + wr * 64 + fr; }
        const int col0 = colt + wc * 32 + 8 * fq;
#pragma unroll
        for (int ai = 0; ai < 2; ++ai)
#pragma unroll
            for (int m = 0; m < 4; ++m) { bf16_t* rowp = base + (size_t)(row0 + ai * 128 + m * 16) * ldc + col0;
#pragma unroll
                for (int bj = 0; bj < 2; ++bj) { const pg8::f32x4 v0 = acc[ai][bj][m][0], v1 = acc[ai][bj][m][1];
                    u32x4 w; w.x = pg8::cvt_pk_bf16(v0[0], v0[1]); w.y = pg8::cvt_pk_bf16(v0[2], v0[3]); w.z = pg8::cvt_pk_bf16(v1[0], v1[1]); w.w = pg8::cvt_pk_bf16(v1[2], v1[3]);
                    *(u32x4*)(rowp + bj * bjs) = w; } }
        if (u.pm != 32 && u.pn >= 6 && u.pn < 14) {
            float* nb = QN2 + (size_t)((u.pn - 6) * 2) * SEQ;
#pragma unroll
            for (int ai = 0; ai < 2; ++ai)
#pragma unroll
                for (int m = 0; m < 4; ++m)
#pragma unroll
                    for (int bj = 0; bj < 2; ++bj) { const pg8::f32x4 v0 = acc[ai][bj][m][0], v1 = acc[ai][bj][m][1];
                        float q = (v0[0] * v0[0] + v0[1] * v0[1]) + (v0[2] * v0[2] + v0[3] * v0[3]) + (v1[0] * v1[0] + v1[1] * v1[1]) + (v1[2] * v1[2] + v1[3] * v1[3]);
                        q += __shfl_xor(q, 16); q += __shfl_xor(q, 32);
                        if (fq == 0) atomicAdd(nb + (size_t)bj * SEQ + row0 + ai * 128 + m * 16, q); }
        }
    }
};
struct SchedTail {
    int c;
    __device__ __forceinline__ bool next(int i, pg8::Unit& u) const {
        if (i != 0 || c >= 136) return false;
        Sched1 S1{256, 0, 4}; pg8::Unit f; S1.c = (c >> 1); if (!S1.next(3, f)) return false;
        u.pm = 2 * f.pm + (c & 1); u.pn = f.pn; return true;
    }
    __device__ __forceinline__ void a_ready(const pg8::Unit&) const {}
    __device__ __forceinline__ void done(const pg8::Unit&) const {}
};
struct Epi1H {
    static constexpr bool PERM = true, AFTER_DRAIN = false;
    bf16_t* P; bf16_t* MKV; float* QN2; bf16_t* KVH;
    __device__ __forceinline__ void operator()(const pg8::f32x4 (&acc)[2][2][4][2], const pg8::Unit& u, int wr, int wc, int fr, int fq) const {
        bf16_t* base; int ldc, colt, row0;
        size_t bjs = 128;
        if (u.pm >= 64) { base = MKV; ldc = 1024; colt = (u.pn - 26) * 256; row0 = (u.pm - 64) * 128 + wr * 64 + fr; }
        else if (u.pn >= 10 && u.pn < 18) { base = KVH + (size_t)((u.pn - 10) * 2) * SEQ * 128; ldc = 128; colt = 0; row0 = u.pm * 128 + wr * 64 + fr; bjs = (size_t)SEQ * 128; }
        else { base = P; ldc = NP; colt = u.pn * 256; row0 = u.pm * 128 + wr * 64 + fr; }
        const int col0 = colt + wc * 32 + 8 * fq;
#pragma unroll
        for (int m = 0; m < 4; ++m) { bf16_t* rowp = base + (size_t)(row0 + m * 16) * ldc + col0;
#pragma unroll
            for (int bj = 0; bj < 2; ++bj) { const pg8::f32x4 v0 = acc[0][bj][m][0], v1 = acc[0][bj][m][1];
                u32x4 w; w.x = pg8::cvt_pk_bf16(v0[0], v0[1]); w.y = pg8::cvt_pk_bf16(v0[2], v0[3]); w.z = pg8::cvt_pk_bf16(v1[0], v1[1]); w.w = pg8::cvt_pk_bf16(v1[2], v1[3]);
                *(u32x4*)(rowp + bj * bjs) = w; } }
        if (u.pm < 64 && u.pn >= 6 && u.pn < 14) {
            float* nb = QN2 + (size_t)((u.pn - 6) * 2) * SEQ;
#pragma unroll
            for (int m = 0; m < 4; ++m)
#pragma unroll
                for (int bj = 0; bj < 2; ++bj) { const pg8::f32x4 v0 = acc[0][bj][m][0], v1 = acc[0][bj][m][1];
                    float q = (v0[0] * v0[0] + v0[1] * v0[1]) + (v0[2] * v0[2] + v0[3] * v0[3]) + (v1[0] * v1[0] + v1[1] * v1[1]) + (v1[2] * v1[2] + v1[3] * v1[3]);
                    q += __shfl_xor(q, 16); q += __shfl_xor(q, 32);
                    if (fq == 0) atomicAdd(nb + (size_t)bj * SEQ + row0 + m * 16, q); }
        }
    }
};
struct Epi2 {
    static constexpr bool PERM = false, AFTER_DRAIN = true;
    const float* x; float* out; float* ss; const float* fg; unsigned* pcnt;
    __device__ __forceinline__ void fused(pg8::f32x4 (&acc)[2][2][4][2], const pg8::Unit& u, int wr, int wc, int fr, int fq, PG8_LAS unsigned char* lds, int wid, int lane) const {
        const int col0 = u.pn * 256 + wc * 32 + 4 * fq;
#pragma unroll
        for (int ai = 0; ai < 2; ++ai)
#pragma unroll
            for (int m = 0; m < 4; ++m) { const int row = u.pm * 256 + ai * 128 + wr * 64 + m * 16 + fr; const size_t off = (size_t)row * DM + col0; float q = 0.f;
#pragma unroll
                for (int bj = 0; bj < 2; ++bj)
#pragma unroll
                    for (int n = 0; n < 2; ++n) { const f32x4 xv = *(const f32x4*)(x + off + bj * 128 + n * 16); const f32x4 o = xv + acc[ai][bj][m][n];
                        acc[ai][bj][m][n] = o; q += (o[0] * o[0] + o[1] * o[1]) + (o[2] * o[2] + o[3] * o[3]); }
                q += __shfl_xor(q, 16); q += __shfl_xor(q, 32);
                if (fq == 0) atomicAdd(ss + row, q);
                if (m == 3) asm volatile("" ::: "memory"); }
        asm volatile("s_waitcnt vmcnt(0)" ::: "memory");
        unsigned* cnt = pcnt + 64 * u.pm;
        if (lane == 0) { __hip_atomic_fetch_add(cnt, 1u, __ATOMIC_RELAXED, __HIP_MEMORY_SCOPE_AGENT);
            while (__hip_atomic_load(cnt, __ATOMIC_RELAXED, __HIP_MEMORY_SCOPE_AGENT) < 64u) __builtin_amdgcn_s_sleep(1); }
        asm volatile("" ::: "memory");
        f32x4 gv[2][2];
#pragma unroll
        for (int bj = 0; bj < 2; ++bj)
#pragma unroll
            for (int n = 0; n < 2; ++n) gv[bj][n] = *(const f32x4*)(fg + col0 + bj * 128 + n * 16);
#pragma unroll
        for (int ai = 0; ai < 2; ++ai)
#pragma unroll
            for (int m = 0; m < 4; ++m) { const int row = u.pm * 256 + ai * 128 + wr * 64 + m * 16 + fr; const size_t off = (size_t)row * DM + col0;
                const float sc = rsqrtf(__hip_atomic_load(ss + row, __ATOMIC_RELAXED, __HIP_MEMORY_SCOPE_AGENT) * (1.f / DM) + EPS);
#pragma unroll
                for (int bj = 0; bj < 2; ++bj)
#pragma unroll
                    for (int n = 0; n < 2; ++n) *(f32x4*)(out + off + bj * 128 + n * 16) = acc[ai][bj][m][n] * sc * gv[bj][n]; }
    }
};

namespace att {
constexpr int D = 128, NW = 8, QBLK = 32, KVBLK = 64, QB = NW * QBLK;
constexpr int SHM_V = KVBLK * D * 2, SHM_K = KVBLK * D * 2;
constexpr int LDS_C = 2 * SHM_V + 2 * SHM_K + NW * 64 * 4;
constexpr int LDS_ATT = LDS_C + 8192 * 4;
constexpr float SCALE = 0.08838834764831845f, THR = 8.f;
constexpr unsigned WBIG = 0x40000000u;
#define KSWZ(row, colB) ((row) * 256 + ((colB) ^ (((row) & 7) << 4)))
#define SBAR() __builtin_amdgcn_sched_barrier(0)
__device__ __forceinline__ int v_st(int k, int c) { const int kk = (k & ~0xC) | ((k & 4) << 1) | ((k & 8) >> 1); return ((kk >> 3) * 4 + (c >> 5)) * 512 + ((kk & 7) * 32 + (c & 31)) * 2; }
__device__ __forceinline__ int v_rd_base(int lane) { return ((lane & 3) << 3) | (((lane >> 2) & 3) << 6) | (((lane >> 4) & 1) << 5) | (((lane >> 5) & 1) << 8); }
constexpr int v_rd_off(int d0, int ks, int half) { return d0 * 512 + ks * 4096 + half * 2048; }
__device__ __forceinline__ int crow(int r, int hi) { return (r & 3) + 8 * (r >> 2) + 4 * hi; }
__device__ __forceinline__ unsigned cvtpk(float lo, float hi) { unsigned r; asm volatile("v_cvt_pk_bf16_f32 %0, %1, %2" : "=v"(r) : "v"(lo), "v"(hi)); return r; }
__device__ __forceinline__ void mask_tile(f32x16& p0, f32x16& p1, int dq, unsigned W) {
    const float NEG = -__builtin_inff();
#pragma unroll
    for (int r = 0; r < 16; ++r) {
        const int c = (r & 3) + 8 * (r >> 2);
        if ((unsigned)(dq - c) >= W) p0[r] = NEG;
        if ((unsigned)(dq - c - 32) >= W) p1[r] = NEG;
    }
}
__device__ __forceinline__ void partialSM(f32x16& p0, f32x16& p1, float& m_reg, float& mn, float& alpha) {
    float pmax = p0[0];
#pragma unroll
    for (int r = 1; r < 16; ++r) pmax = fmaxf(pmax, p0[r]);
#pragma unroll
    for (int r = 0; r < 16; ++r) pmax = fmaxf(pmax, p1[r]);
    { auto rr = __builtin_amdgcn_permlane32_swap(__float_as_uint(pmax), __float_as_uint(pmax), false, false);
      pmax = fmaxf(__uint_as_float(rr[0]), __uint_as_float(rr[1])); }
    constexpr float C2 = 1.4426950408889634f * SCALE;
    if (__builtin_expect(__all((pmax - m_reg) * SCALE <= THR), 1)) { mn = m_reg; alpha = 1.f; }
    else { mn = fmaxf(m_reg, pmax); alpha = __builtin_amdgcn_exp2f((m_reg - mn) * C2); m_reg = mn; }
    const float mnL = -mn * C2;
#pragma unroll
    for (int r = 0; r < 16; ++r) p0[r] = fmaf(p0[r], C2, mnL);
#pragma unroll
    for (int r = 0; r < 16; ++r) p1[r] = fmaf(p1[r], C2, mnL);
#pragma unroll
    for (int r = 0; r < 16; ++r) p0[r] = __builtin_amdgcn_exp2f(p0[r]);
}
__device__ __forceinline__ void finishSM(f32x16& p0, f32x16& p1, float alpha, float& l_reg, bf16x8& pa0, bf16x8& pa1, bf16x8& pa2, bf16x8& pa3) {
#pragma unroll
    for (int r = 0; r < 16; ++r) p1[r] = __builtin_amdgcn_exp2f(p1[r]);
    float ps = 0;
#pragma unroll
    for (int r = 0; r < 16; ++r) ps += p0[r];
#pragma unroll
    for (int r = 0; r < 16; ++r) ps += p1[r];
    { auto rr = __builtin_amdgcn_permlane32_swap(__float_as_uint(ps), __float_as_uint(ps), false, false);
      ps = __uint_as_float(rr[0]) + __uint_as_float(rr[1]); }
    l_reg = l_reg * alpha + ps;
#define PK4(P, B_, OUT) do { unsigned a0 = cvtpk(P[B_+0], P[B_+1]), a1 = cvtpk(P[B_+2], P[B_+3]);                          \
        unsigned b0 = cvtpk(P[B_+4], P[B_+5]), b1 = cvtpk(P[B_+6], P[B_+7]);                                             \
        auto r0 = __builtin_amdgcn_permlane32_swap(a0, b0, false, false); auto r1 = __builtin_amdgcn_permlane32_swap(a1, b1, false, false); \
        u32x4 w = {r0[0], r1[0], r0[1], r1[1]}; OUT = *reinterpret_cast<bf16x8*>(&w); } while (0)
    PK4(p0, 0, pa0); PK4(p0, 8, pa1); PK4(p1, 0, pa2); PK4(p1, 8, pa3);
#undef PK4
}
template <int KB>
__device__ __forceinline__ void qkt(f32x16& p0, f32x16& p1, const char* K_lds, int r32, int hi, const bf16x8* qr, const float* cb, float cq) {
#ifdef ATT_NO_BIAS
    p0 = f32x16{}; p1 = f32x16{};
#else
#pragma unroll
    for (int g = 0; g < 4; ++g) { const f32x4 a = *(const f32x4*)(cb + 8 * g), b = *(const f32x4*)(cb + 32 + 8 * g);
#pragma unroll
        for (int j = 0; j < 4; ++j) { p0[4 * g + j] = cq - a[j]; p1[4 * g + j] = cq - b[j]; } }
#endif
    const char* kb[4];
#pragma unroll
    for (int dd = 0; dd < 4; ++dd) kb[dd] = K_lds + KB * SHM_K + KSWZ(r32, (dd * 16 + hi * 8) * 2);
#pragma unroll
    for (int d0 = 0; d0 < 8; ++d0) { const char* a = kb[d0 & 3] + (d0 >> 2) * 128;
        bf16x8 b0 = *reinterpret_cast<const bf16x8*>(a);
        bf16x8 b1 = *reinterpret_cast<const bf16x8*>(a + 32 * 256);
        p0 = __builtin_amdgcn_mfma_f32_32x32x16_bf16(b0, qr[d0], p0, 0, 0, 0);
        p1 = __builtin_amdgcn_mfma_f32_32x32x16_bf16(b1, qr[d0], p1, 0, 0, 0); }
}
template <int VB>
__device__ __forceinline__ void pv_tile(f32x16* o, int vb0, bf16x8 pa0, bf16x8 pa1, bf16x8 pa2, bf16x8 pa3) {
#define TRRD(dst, off) asm volatile("ds_read_b64_tr_b16 %0, %1 offset:%2" : "=&v"(dst) : "v"(vb0), "i"(off) : "memory")
#define PV_D0(d0) do { s16x4 l0, l1, l2, l3, h0, h1, h2, h3; constexpr int b_ = VB * SHM_V + v_rd_off(d0, 0, 0); \
        TRRD(l0, b_); TRRD(h0, b_ + 2048); TRRD(l1, b_ + 4096); TRRD(h1, b_ + 6144); TRRD(l2, b_ + 8192); TRRD(h2, b_ + 10240); TRRD(l3, b_ + 12288); TRRD(h3, b_ + 14336); \
        asm volatile("s_waitcnt lgkmcnt(0)" ::: "memory"); SBAR(); \
        o[d0] = __builtin_amdgcn_mfma_f32_32x32x16_bf16(pa0, (bf16x8){l0[0], l0[1], l0[2], l0[3], h0[0], h0[1], h0[2], h0[3]}, o[d0], 0, 0, 0);   \
        o[d0] = __builtin_amdgcn_mfma_f32_32x32x16_bf16(pa1, (bf16x8){l1[0], l1[1], l1[2], l1[3], h1[0], h1[1], h1[2], h1[3]}, o[d0], 0, 0, 0);   \
        o[d0] = __builtin_amdgcn_mfma_f32_32x32x16_bf16(pa2, (bf16x8){l2[0], l2[1], l2[2], l2[3], h2[0], h2[1], h2[2], h2[3]}, o[d0], 0, 0, 0);   \
        o[d0] = __builtin_amdgcn_mfma_f32_32x32x16_bf16(pa3, (bf16x8){l3[0], l3[1], l3[2], l3[3], h3[0], h3[1], h3[2], h3[3]}, o[d0], 0, 0, 0); } while (0)
    PV_D0(0); PV_D0(1); PV_D0(2); PV_D0(3);
#undef PV_D0
#undef TRRD
}
struct BlockRef { const bf16_t* Q; const bf16_t* K; const float* C; bf16_t* O; int voff, goff, P0, skv, pkv, jlo, c0i; };
struct Seam { bf16x8 qr[8]; bf16x8 st_v0, st_v1, st_k0, st_k1; };
#define VMW() asm volatile("s_waitcnt vmcnt(0)" ::: "memory")
#define VMWN(n) asm volatile("s_waitcnt vmcnt(%0)" :: "i"(n) : "memory")
#define SLOAD_H(Kp, Vp, pitch, k0, roff) do { const char* kb_ = (const char*)(Kp) + (size_t)(k0) * (size_t)(pitch) * 2; const char* vb_ = (const char*)(Vp) + (size_t)(k0) * (size_t)(pitch) * 2; \
        S.st_v0 = LD8(vb_ + (roff)); S.st_v1 = LD8(vb_ + (size_t)(pitch) * 64 + (roff)); S.st_k0 = LD8(kb_ + (roff)); S.st_k1 = LD8(kb_ + (size_t)(pitch) * 64 + (roff)); } while (0)
#define SWRITE_HK(bf) do { *(bf16x8*)(K_lds + (bf) * SHM_K + kws) = S.st_k0; *(bf16x8*)(K_lds + (bf) * SHM_K + kws + 32 * 256) = S.st_k1; } while (0)
#define SWRITE_HV(bf) do { *(bf16x8*)(V_lds + (bf) * SHM_V + vst0) = S.st_v0; *(bf16x8*)(V_lds + (bf) * SHM_V + vst1) = S.st_v1; } while (0)
#define SWRITE_H(bf) do { SWRITE_HV(bf); SWRITE_HK(bf); } while (0)
__device__ __forceinline__ void prime(const BlockRef& cur, char* lds, Seam& S, const int wid) {
    const int lane = lane_id(), tid = wid * 64 + lane, r32 = lane & 31, hi = lane >> 5;
    const int sr = tid >> 4, sc = (tid & 15) * 8, kws = KSWZ(sr, sc * 2); char* K_lds = lds + 2 * SHM_V;
    const int kb0 = cur.jlo * KVBLK;
#pragma unroll
    for (int d0 = 0; d0 < 8; ++d0) S.qr[d0] = LD8((const char*)(cur.Q + (size_t)(wid * QBLK) * NP) + (unsigned)((r32 * NP + hi * 8) * 2) + d0 * 32);
    const unsigned roff = (unsigned)(sr * cur.pkv + sc) * 2u;
    SLOAD_H(cur.K, cur.K + cur.voff, cur.pkv, kb0, roff); VMW(); SWRITE_HK(0);
    __syncthreads();
}
__device__ __forceinline__ void block(const BlockRef& cur, const BlockRef& nxt, char* lds, Seam& S, const int wid) {
    const int lane = lane_id(), tid = wid * 64 + lane, r32 = lane & 31, hi = lane >> 5;
    const int j_lo = cur.jlo;
    int j_hi = (cur.P0 + QB - 1) / KVBLK + 1; if (j_hi > cur.skv / KVBLK) j_hi = cur.skv / KVBLK;
    const int NT = j_hi - j_lo;
    const int kbn = nxt.jlo * KVBLK;
    const int qlo = cur.P0 + wid * QBLK, qm = qlo + r32 - 4 * hi;
    char* V_lds = lds; char* K_lds = lds + 2 * SHM_V;
    float* ws = (float*)(lds + 2 * SHM_V + 2 * SHM_K) + wid * 64; float* li_l = ws, * al_l = ws + 32;
    float* c_l = (float*)(lds + LDS_C);
#ifdef ATT_NO_BIAS
    if (0)
#endif
    {   const int n = j_hi * KVBLK; const float* Cg = cur.C; const float c0 = Cg[cur.c0i];
#pragma unroll 1
#ifdef ATT_BIAS_NOFILL
        for (int i = j_lo * KVBLK + tid; i < n; i += 512) c_l[i] = c0 * 0.f;
#else
        for (int i = j_lo * KVBLK + tid; i < n; i += 512) c_l[i] = (Cg[i] - c0) * (1.f / SCALE);
#endif
        __syncthreads(); }
#ifdef ATT_NO_BIAS
    const float cq = 0.f;
#else
    const float cq = c_l[cur.c0i + wid * QBLK + r32];
#endif
    float m_reg = -1e30f, l_reg = 0; f32x16 o[4] = {};
    const int sr = tid >> 4, sc = (tid & 15) * 8, vst0 = v_st(sr, sc), vst1 = v_st(32 + sr, sc), kws = KSWZ(sr, sc * 2);
    const int vb0 = (int)(uintptr_t)V_lds + v_rd_base(lane);
    const bf16_t* Kh = cur.K; const bf16_t* Vh = cur.K + cur.voff; const int pkv = cur.pkv; const unsigned roff = (unsigned)(sr * pkv + sc) * 2u;
#define RESC(a) do { if (__any((a) < 1.f)) { if (hi == 0) al_l[r32] = (a); asm volatile("s_waitcnt lgkmcnt(0)" ::: "memory");              \
                     for (int d_ = 0; d_ < 4; ++d_) for (int r = 0; r < 16; ++r) o[d_][r] *= al_l[crow(r, hi)]; } } while (0)
#define KBASE(t) ((j_lo + (t)) * KVBLK)
#define MASKT(P0_, P1_, t) do { const int kb_ = KBASE(t); if (kb_ + KVBLK - 1 > qlo) mask_tile(P0_, P1_, qm - kb_, WBIG); } while (0)
#define QKT(KB, P0_, P1_, t) qkt<KB>(P0_, P1_, K_lds, r32, hi, S.qr, c_l + KBASE(t) + 4 * hi, cq)
    constexpr int NQL = 8;
#define SEAM_K0() do { VMWN(NQL); SWRITE_HK(0); SBAR(); } while (0)
    f32x16 pA0, pA1, pB0, pB1; float mnA, mnB, alA, alB; bf16x8 pa0, pa1, pa2, pa3;
    SWRITE_HV(0); SBAR();
    if (NT > 1) { SLOAD_H(Kh, Vh, pkv, KBASE(1), roff); }
    SBAR(); QKT(0, pA0, pA1, 0);
    MASKT(pA0, pA1, 0); partialSM(pA0, pA1, m_reg, mnA, alA);
    if (NT > 1) { VMW(); SWRITE_H(1); }
    __syncthreads();
#define HALF_STEP(PX0, PX1, mnX, alX, PY0, PY1, alY, t, KB, VB, SB) do {                                                      \
        SBAR(); QKT(KB, PX0, PX1, t);                                                                                         \
        finishSM(PY0, PY1, alY, l_reg, pa0, pa1, pa2, pa3); SBAR();                                                           \
        if ((t) + 1 < NT) { SLOAD_H(Kh, Vh, pkv, KBASE((t) + 1), roff); SBAR(); }                                                   \
        pv_tile<VB>(o, vb0, pa0, pa1, pa2, pa3); MASKT(PX0, PX1, (t)); partialSM(PX0, PX1, m_reg, mnX, alX);                  \
        __syncthreads();                                                                                                      \
        if ((t) + 1 < NT) { VMW(); SWRITE_H(SB); }                                                                            \
        RESC(alX); __syncthreads(); } while (0)
    for (int t = 1; t + 1 < NT; t += 2) {
        HALF_STEP(pB0, pB1, mnB, alB, pA0, pA1, alA, t, 1, 0, 0);
        HALF_STEP(pA0, pA1, mnA, alA, pB0, pB1, alB, t + 1, 0, 1, 1);
    }
    const bool even = (NT & 1) == 0;
    if (even) { SBAR(); QKT(1, pB0, pB1, NT - 1); SBAR(); }
    { const unsigned roffn = (unsigned)(sr * nxt.pkv + sc) * 2u; SLOAD_H(nxt.K, nxt.K + nxt.voff, nxt.pkv, kbn, roffn); } SBAR();
#pragma unroll
    for (int d0 = 0; d0 < 8; ++d0) S.qr[d0] = LD8((const char*)(nxt.Q + (size_t)(wid * QBLK) * NP) + (unsigned)((r32 * NP + hi * 8) * 2) + d0 * 32);
    SBAR();
    finishSM(pA0, pA1, alA, l_reg, pa0, pa1, pa2, pa3); SBAR();
    pv_tile<0>(o, vb0, pa0, pa1, pa2, pa3);
    if (even) { MASKT(pB0, pB1, NT - 1); partialSM(pB0, pB1, m_reg, mnB, alB); __syncthreads(); RESC(alB);
        finishSM(pB0, pB1, alB, l_reg, pa0, pa1, pa2, pa3); SBAR(); pv_tile<1>(o, vb0, pa0, pa1, pa2, pa3); }
    SBAR(); SEAM_K0();
    int lane_e = lane; asm volatile("" : "+v"(lane_e));
    const int r32e = lane_e & 31, hie = lane_e >> 5;
    if (hie == 0) li_l[r32e] = l_reg; asm volatile("s_waitcnt lgkmcnt(0)" ::: "memory");
    float rli[16];
#pragma unroll
    for (int r = 0; r < 16; ++r) rli[r] = __builtin_amdgcn_rcpf(li_l[crow(r, hie)]);
    __syncthreads();
#ifndef ATT_NO_EPI
    bf16x8 gt[8];
    { const bf16_t* Gw = cur.Q + cur.goff + (size_t)(wid * QBLK + (lane_e >> 4)) * NP + (lane_e & 15) * 8;
#pragma unroll
      for (int i = 0; i < 8; ++i) gt[i] = LD8(Gw + (size_t)(i * 4) * NP); }
    SBAR();
    char* stg = lds + LDS_C + wid * 8704;
#pragma unroll
    for (int r = 0; r < 16; ++r) { const int orow = crow(r, hie);
#pragma unroll
        for (int d0 = 0; d0 < 4; ++d0) *(bf16_t*)(stg + orow * 272 + (d0 * 32 + r32e) * 2) = (bf16_t)f2bf(o[d0][r] * rli[r]); }
    asm volatile("s_waitcnt lgkmcnt(0)" ::: "memory");
    { bf16_t* Ow = cur.O + (size_t)(wid * QBLK + (lane_e >> 4)) * DM + (lane_e & 15) * 8;
#pragma unroll
      for (int i = 0; i < 8; ++i) { const bf16x8 ov = *(const bf16x8*)(stg + (i * 4 + (lane_e >> 4)) * 272 + (lane_e & 15) * 16); float v[8];
#pragma unroll
          for (int e = 0; e < 8; ++e) { const float g = bf2f((unsigned short)gt[i][e]); v[e] = bf2f((unsigned short)ov[e]) * g * sigmoidf_(g); }
          u32x4 w = {cvtpk(v[0], v[1]), cvtpk(v[2], v[3]), cvtpk(v[4], v[5]), cvtpk(v[6], v[7])};
          *(u32x4*)(Ow + (size_t)(i * 4) * DM) = w; } }
#endif
    __syncthreads();
#undef RESC
#undef KBASE
#undef MASKT
#undef QKT
#undef SEAM_K0
#undef HALF_STEP
}
#undef VMW
#undef VMWN
#undef SLOAD_H
#undef SWRITE_HK
#undef SWRITE_HV
#undef SWRITE_H
}

__device__ __forceinline__ int compute_jlo(const att::BlockRef& r, char* lds, int wid) {
    if (r.P0 >= SEQ) return 0;
    const int lane_ = lane_id(), tid_ = wid * 64 + lane_;
    const float* Cg = r.C; const float* QN = Cg + 8 * SEQ; const float* KN = Cg + 16 * SEQ;
    float* red = (float*)(lds + 138240);
    float qm = 0.f, km = 0.f;
    if (tid_ < 256) { qm = QN[r.P0 + tid_]; km = KN[r.P0 + tid_]; }
#pragma unroll
    for (int o = 1; o < 64; o <<= 1) { qm = fmaxf(qm, __shfl_xor(qm, o)); km = fmaxf(km, __shfl_xor(km, o)); }
    if (lane_ == 0) { red[wid] = qm; red[8 + wid] = km; }
    __syncthreads();
    qm = fmaxf(fmaxf(red[0], red[1]), fmaxf(red[2], red[3])); km = fmaxf(fmaxf(red[8], red[9]), fmaxf(red[10], red[11]));
    const float A = att::SCALE * 1.02f * sqrtf(qm), Kd = 1.02f * sqrtf(km), c0 = Cg[r.P0], THETA = 30.f;
    int smin = r.P0;
    for (int s = tid_; s < r.P0; s += 512) { const float thr = A * (1.02f * sqrtf(KN[s]) + Kd) + THETA; if (!(Cg[s] - c0 >= thr)) smin = min(smin, s); }
#pragma unroll
    for (int o = 1; o < 64; o <<= 1) smin = min(smin, __shfl_xor(smin, o));
    __syncthreads();
    if (lane_ == 0) ((int*)red)[16 + wid] = smin;
    __syncthreads();
    const int* ri = (const int*)red + 16;
    smin = min(min(min(ri[0], ri[1]), min(ri[2], ri[3])), min(min(ri[4], ri[5]), min(ri[6], ri[7])));
    return smin / att::KVBLK;
}

__device__ __forceinline__ bool get_attn(int b, int n, unsigned char* ws, att::BlockRef& r) {
    const bf16_t* P = (const bf16_t*)(ws + WS_P); bf16_t* Y = (bf16_t*)(ws + WS_Y);
#ifdef PROBE_DUPFOX
    if (n >= 1) --n;
    else n = 0;
#endif
    if (n == 0) {
        const int h = b & 7, qb = 31 - (b >> 3);
        r.Q = P + (size_t)(qb * 256) * NP + C_FQ + h * 128; r.K = (const bf16_t*)(ws + WS_KVH) + (size_t)h * SEQ * 128; r.voff = 8 * SEQ * 128; r.goff = C_FG - C_FQ;
        r.C = (const float*)(ws + WS_CS) + h * SEQ; r.O = Y + (size_t)(qb * 256) * DM + Y_FOX + h * 128; r.P0 = qb * 256; r.skv = SEQ; r.pkv = 128; r.jlo = 0; r.c0i = qb * 256; return true; }
    if (n == 1 && b >= 128) {
        const int m = 255 - b, h = m & 3, qb = m >> 2; const bf16_t* MKV = (const bf16_t*)(ws + WS_MKV);
        r.Q = P + (size_t)(qb * 256) * NP + C_MQ + h * 128; r.K = MKV + h * 128; r.voff = 512; r.goff = C_MG - C_MQ;
        r.C = (const float*)(ws + WS_SS); r.O = Y + (size_t)(qb * 256) * DM + Y_MEM + h * 128; r.P0 = 1 << 20; r.skv = MEMLEN; r.pkv = 1024; r.jlo = 0; r.c0i = 0; return true; }
    return false;
}

__device__ __forceinline__ void conv_item(int t0, const bf16_t* P, const float* conv_w, const float* conv_b, const float* ln_g, const float* ln_b,
                                          const bf16_t* WpwT, bf16_t* Y, char* lds, const int wid) {
    const int lane = lane_id(), tid = wid * 64 + lane;
    float* U = (float*)lds; float* Yc = (float*)lds; float* stat = (float*)(lds + 129024); bf16_t* At = (bf16_t*)lds;
    const int r32 = lane & 31, hi = lane >> 5, nb = wid * 64;
    const bf16_t* w0p = WpwT + (size_t)(nb + r32) * 512 + hi * 8; const bf16_t* w1p = w0p + 32 * 512;
    bf16x8 wA[16], wB[16];
#define WLOAD(dst, batch) do { _Pragma("unroll") for (int q_ = 0; q_ < 8; ++q_) { dst[2 * q_] = LD8(w0p + ((batch) * 8 + q_) * 16); dst[2 * q_ + 1] = LD8(w1p + ((batch) * 8 + q_) * 16); } } while (0)
    WLOAD(wA, 0);
#pragma unroll
    for (int i = 0; i < 8; ++i) { const int idx = tid + i * 512, r = idx >> 6, ch = (idx & 63) * 8;
        if (r < 62) { const int tok = t0 - 30 + r; f32x4 u0 = {0.f, 0.f, 0.f, 0.f}, u1 = u0;
            if (tok >= 0) { const bf16x8 a = LD8(P + (size_t)tok * NP + C_CVA + ch), b = LD8(P + (size_t)tok * NP + C_CVB + ch);
#pragma unroll
                for (int e = 0; e < 4; ++e) { u0[e] = bf2f((unsigned short)a[e]) * sigmoidf_(bf2f((unsigned short)b[e])); u1[e] = bf2f((unsigned short)a[4 + e]) * sigmoidf_(bf2f((unsigned short)b[4 + e])); } }
            *(f32x4*)(U + r * 512 + ch) = u0; *(f32x4*)(U + r * 512 + ch + 4) = u1; } }
    __syncthreads();
    const int c = tid;
    float acc[32];
    { float w[31];
#pragma unroll
      for (int k = 0; k < 31; ++k) w[k] = conv_w[k * 512 + c];
      const float bias = conv_b[c];
#pragma unroll
      for (int t = 0; t < 32; ++t) acc[t] = bias;
#pragma unroll
      for (int r = 0; r < 62; ++r) { const float uv = U[r * 512 + c];
#pragma unroll
          for (int t = 0; t < 32; ++t) { if (r - t >= 0 && r - t <= 30) acc[t] = fmaf(w[r - t], uv, acc[t]); } } }
    __syncthreads();
#pragma unroll
    for (int t = 0; t < 32; ++t) Yc[t * 512 + c] = acc[t];
    __syncthreads();
#pragma unroll
    for (int q = 0; q < 4; ++q) { const int t = wid * 4 + q; const f32x4 a = *(const f32x4*)(Yc + t * 512 + lane * 8), bq = *(const f32x4*)(Yc + t * 512 + lane * 8 + 4);
        float s1 = (a[0] + a[1]) + (a[2] + a[3]) + (bq[0] + bq[1]) + (bq[2] + bq[3]);
        float s2 = (a[0] * a[0] + a[1] * a[1]) + (a[2] * a[2] + a[3] * a[3]) + (bq[0] * bq[0] + bq[1] * bq[1]) + (bq[2] * bq[2] + bq[3] * bq[3]);
#pragma unroll
        for (int o = 1; o < 64; o <<= 1) { s1 += __shfl_xor(s1, o); s2 += __shfl_xor(s2, o); }
        if (lane == 0) { const float mean = s1 * (1.f / 512.f), var = s2 * (1.f / 512.f) - mean * mean; stat[t * 2] = mean; stat[t * 2 + 1] = rsqrtf(fmaxf(var, 0.f) + EPS); } }
    __syncthreads();
    { const float g = ln_g[c], be = ln_b[c];
#pragma unroll
        for (int t = 0; t < 32; ++t) { const float y = (acc[t] - stat[2 * t]) * stat[2 * t + 1] * g + be; At[t * 520 + c] = (bf16_t)f2bf(y * sigmoidf_(y)); } }
    s16x4 gt[8];
    { const int tok = t0 + r32;
#pragma unroll
      for (int blk = 0; blk < 2; ++blk)
#pragma unroll
          for (int g4 = 0; g4 < 4; ++g4) gt[blk * 4 + g4] = *(const s16x4*)(P + (size_t)tok * NP + C_CVG + nb + blk * 32 + 8 * g4 + 4 * hi); }
    __syncthreads();
    f32x16 o0 = {}, o1 = {};
    const bf16_t* ap = At + r32 * 520 + hi * 8;
#define WMMA(src, batch) do { _Pragma("unroll") for (int q_ = 0; q_ < 8; ++q_) { const bf16x8 zf = LD8(ap + ((batch) * 8 + q_) * 16); \
        o0 = __builtin_amdgcn_mfma_f32_32x32x16_bf16(src[2 * q_], zf, o0, 0, 0, 0); o1 = __builtin_amdgcn_mfma_f32_32x32x16_bf16(src[2 * q_ + 1], zf, o1, 0, 0, 0); } } while (0)
    WLOAD(wB, 1); WMMA(wA, 0);
    WLOAD(wA, 2); WMMA(wB, 1);
    WLOAD(wB, 3); WMMA(wA, 2);
    WMMA(wB, 3);
#undef WLOAD
#undef WMMA
    { const int tok = t0 + r32;
#pragma unroll
        for (int blk = 0; blk < 2; ++blk)
#pragma unroll
            for (int g4 = 0; g4 < 4; ++g4) { const int n = nb + blk * 32 + 8 * g4 + 4 * hi; const s16x4 gtv = gt[blk * 4 + g4];
                float v[4];
#pragma unroll
                for (int j = 0; j < 4; ++j) { const float gv = bf2f((unsigned short)gtv[j]); v[j] = (blk ? o1[4 * g4 + j] : o0[4 * g4 + j]) * gv * sigmoidf_(gv); }
                u32x2 pk; pk.x = pk2(v[0], v[1]); pk.y = pk2(v[2], v[3]); *(u32x2*)(Y + (size_t)tok * DM + Y_CONV + n) = pk; } }
    __syncthreads();
}

struct TrItem { const float* src; bf16_t* dst; int srcN, K; };
__device__ __forceinline__ void tr_decode(int it, const float* w_in, const float* w_kv, const float* w_out, const float* w_pw, unsigned char* ws, TrItem& t) {
    constexpr int I_IN = 32 * (NP / 32), I_KV = 32 * 32, I_OUT = 32 * 64;
    const float* W; bf16_t* WT; int srcN, K, ncols, shift = 1 << 30, r = it;
    if (r < I_IN) { W = w_in; WT = (bf16_t*)(ws + WS_B); srcN = DIN; K = DM; ncols = NP; shift = FCOL; }
    else if (r < I_IN + I_KV) { r -= I_IN; W = w_kv; WT = (bf16_t*)(ws + WS_WKV); srcN = 1024; K = DM; ncols = 1024; }
    else if (r < I_IN + I_KV + I_OUT) { r -= I_IN + I_KV; W = w_out; WT = (bf16_t*)(ws + WS_WOUT); srcN = DM; K = DM; ncols = DM; }
    else { r -= I_IN + I_KV + I_OUT; W = w_pw; WT = (bf16_t*)(ws + WS_WPW); srcN = 512; K = 512; ncols = 512; }
    const int nblk = ncols / 32, kb = r / nblk, nb = r % nblk, k0 = 64 * kb, n0 = 32 * nb, sn0 = n0 + (n0 >= shift ? 8 : 0);
    t.src = W + (size_t)k0 * srcN + sn0; t.dst = WT + (size_t)n0 * K + k0; t.srcN = srcN; t.K = K;
}
__device__ __forceinline__ void tr_load(float (&buf)[32], const TrItem& t, int lane) {
    const float* p = t.src + (size_t)(lane >> 5) * t.srcN + (lane & 31);
#pragma unroll
    for (int i = 0; i < 32; ++i) buf[i] = __builtin_nontemporal_load(p + (size_t)(2 * i) * t.srcN);
}
__device__ __forceinline__ void tr_store(const float (&buf)[32], const TrItem& t, float* scr, int lane) {
#pragma unroll
    for (int i = 0; i < 32; ++i) scr[(2 * i + (lane >> 5)) * 33 + (lane & 31)] = buf[i];
    asm volatile("s_waitcnt lgkmcnt(0)" ::: "memory");
    const int c = lane & 7;
#pragma unroll
    for (int j = 0; j < 4; ++j) { const int n = (lane >> 3) + 8 * j; const float* s = scr + (8 * c) * 33 + n;
        u32x4 o; o.x = pk2(s[0 * 33], s[1 * 33]); o.y = pk2(s[2 * 33], s[3 * 33]); o.z = pk2(s[4 * 33], s[5 * 33]); o.w = pk2(s[6 * 33], s[7 * 33]);
        *(u32x4*)(t.dst + (size_t)n * t.K + 8 * c) = o; }
    asm volatile("s_waitcnt lgkmcnt(0)" ::: "memory");
}
__device__ __forceinline__ void transposes(int it0, int it1, int gw, int NGW, const float* w_in, const float* w_kv, const float* w_out, const float* w_pw, unsigned char* ws, float* scr, int lane) {
    TrItem tc, tn; float bc[32], bn[32]; int it = it0 + gw;
    if (it < it1) { tr_decode(it, w_in, w_kv, w_out, w_pw, ws, tc); tr_load(bc, tc, lane); }
    while (it < it1) { const int itn = it + NGW; const bool hn = itn < it1;
        if (hn) { tr_decode(itn, w_in, w_kv, w_out, w_pw, ws, tn); tr_load(bn, tn, lane); }
        tr_store(bc, tc, scr, lane);
        if (hn) { tc = tn;
#pragma unroll
            for (int i = 0; i < 32; ++i) bc[i] = bn[i]; }
        it = itn; }
}
__device__ __forceinline__ void norm_row(f32x4 (&v)[8], const f32x4 (&gv)[8], bf16_t* orow, int lane, const float* wf_lds, f32x4* rowbuf, const float* b_f, float* logf_out  ) {
    float s = 0.f;
#pragma unroll
    for (int j = 0; j < 8; ++j) s += (v[j].x * v[j].x + v[j].y * v[j].y) + (v[j].z * v[j].z + v[j].w * v[j].w);
    const float rstd = rsqrtf(wave_sum(s) * (1.f / DM) + EPS);
#pragma unroll
    for (int j = 0; j < 8; ++j) v[j] = v[j] * rstd * gv[j];
    unsigned long long* o8 = (unsigned long long*)orow + lane;
#pragma unroll
    for (int j = 0; j < 8; ++j) o8[64 * j] = (unsigned long long)pk2(v[j].x, v[j].y) | ((unsigned long long)pk2(v[j].z, v[j].w) << 32);
    if (wf_lds) {
#pragma unroll
        for (int j = 0; j < 8; ++j) rowbuf[64 * j + lane] = v[j];
        asm volatile("s_waitcnt lgkmcnt(0)" ::: "memory");
        f32x4 f0 = {0.f, 0.f, 0.f, 0.f}, f1 = f0; const f32x4* wf = (const f32x4*)wf_lds + lane;
#pragma unroll 1
        for (int j = 0; j < 8; ++j) { const f32x4 hv = rowbuf[64 * j + lane]; const f32x4* wj = wf + 512 * j;
#pragma unroll
            for (int i = 0; i < 4; ++i) { f0 += hv[i] * wj[128 * i]; f1 += hv[i] * wj[128 * i + 64]; } }
        float f[8] = {f0[0], f0[1], f0[2], f0[3], f1[0], f1[1], f1[2], f1[3]};
        float zsel = 0.f;
#pragma unroll
        for (int h = 0; h < 8; ++h) { const float z = wave_sum(f[h]) + b_f[h]; zsel = (lane == h) ? z : zsel; }
        const float ls = fminf(zsel, 0.f) - log1pf(__expf(-fabsf(zsel)));
        if (lane < 8) logf_out[(size_t)lane * SEQ] = ls;
    }
}
__device__ __forceinline__ void row_load(f32x4 (&v)[8], const float* row, int lane) {
    const f32x4* xr = (const f32x4*)row + lane;
#pragma unroll
    for (int j = 0; j < 8; ++j) v[j] = __builtin_nontemporal_load(xr + 64 * j);
}

__device__ __forceinline__ const void* lds_ptr(const unsigned char* lds, int k) {
    const unsigned lo = *(const volatile unsigned*)(lds + 146944 + 8 * k), hi = *(const volatile unsigned*)(lds + 146944 + 8 * k + 4);
    return (const void*)(((unsigned long long)(unsigned)__builtin_amdgcn_readfirstlane((int)hi) << 32) | (unsigned)__builtin_amdgcn_readfirstlane((int)lo));
}
#define GAS __attribute__((address_space(1)))
#define XB_TMO      128
#define XB_XCNT(j)  (256  + 64 * (j))
#define XB_XSUB(j)  (1280 + 64 * (j))
#define XB_XGEN(j)  (2304 + 64 * (j))
#define XB_TOP      3328
#define XB_TOPGEN   3392
#define XCD_BAR_WORDS 3456
#define XB_SPIN_CAP (1u << 18)

__device__ __forceinline__ unsigned xb_ld(unsigned* p)              { return __hip_atomic_load(p, __ATOMIC_RELAXED, __HIP_MEMORY_SCOPE_AGENT); }
__device__ __forceinline__ unsigned xb_add(unsigned* p, unsigned v) { return __hip_atomic_fetch_add(p, v, __ATOMIC_RELAXED, __HIP_MEMORY_SCOPE_AGENT); }
__device__ __forceinline__ unsigned xb_xcc_id() { return (unsigned)__builtin_amdgcn_s_getreg((3 << 11) | 20) & 0xFu; }
#define XB_SPIN(cond, bar) do { unsigned _sp = 0; while (cond) { __builtin_amdgcn_s_sleep(1); \
    if ((++_sp & 255u) == 0u) { if (xb_ld(&(bar)[XB_TMO])) break; if (_sp > XB_SPIN_CAP) { atomicAdd(&(bar)[XB_TMO], 1u); break; } } } } while (0)

struct XcdBarrier {
    unsigned* bar; unsigned x;
    volatile LAS unsigned* st;
};

__device__ __forceinline__ XcdBarrier xcd_barrier_post(unsigned* bar, volatile LAS unsigned* st, bool is0) {
    XcdBarrier b; b.bar = bar; b.x = xb_xcc_id(); b.st = st;
    if (is0) (void)xb_add(&bar[XB_XCNT(b.x)], 1u);
    return b;
}
__device__ __forceinline__ void xcd_barrier_complete(unsigned* bar, unsigned x, unsigned& nloc, unsigned& nx) {
    const unsigned G = gridDim.x * gridDim.y * gridDim.z;
    unsigned sum, cnt, mine, sp = 0u;
    for (;;) {
        sum = 0u; cnt = 0u; mine = 0u;
#pragma unroll
        for (unsigned j = 0; j < 16; ++j) { const unsigned c = xb_ld(&bar[XB_XCNT(j)]); sum += c; cnt += (c > 0u) ? 1u : 0u; mine = (j == x) ? c : mine; }
        if (sum == G) break;
        __builtin_amdgcn_s_sleep(1);
        if ((++sp & 255u) == 0u) { if (xb_ld(&bar[XB_TMO])) break; if (sp > XB_SPIN_CAP) { atomicAdd(&bar[XB_TMO], 1u); break; } }
    }
    nloc = mine > 0u ? mine : 1u; nx = cnt > 0u ? cnt : 1u;
}

__device__ __forceinline__ void xcd_barrier(const XcdBarrier& b, bool is0) {
    asm volatile("s_waitcnt vmcnt(0)" ::: "memory");
    __syncthreads();
    if (is0) {
        unsigned* bar = b.bar;
        __builtin_amdgcn_s_waitcnt(0);
        unsigned nloc = b.st[0], nx = b.st[1];
        if (nloc == 0u) { xcd_barrier_complete(bar, b.x, nloc, nx); b.st[0] = nloc; b.st[1] = nx; }
        const unsigned old = xb_add(&bar[XB_XSUB(b.x)], 1u);
        const unsigned gen = old / nloc;
        if (old + 1u == (gen + 1u) * nloc) {
            __builtin_amdgcn_fence(__ATOMIC_RELEASE, "agent");
            asm volatile("s_waitcnt vmcnt(0)" ::: "memory");
            const unsigned og = xb_add(&bar[XB_TOP], 1u);
            const unsigned tg = og / nx;
            if (og + 1u == (tg + 1u) * nx) xb_add(&bar[XB_TOPGEN], 1u);
            else XB_SPIN(xb_ld(&bar[XB_TOPGEN]) == tg, bar);
            __builtin_amdgcn_fence(__ATOMIC_ACQUIRE, "agent");
            xb_add(&bar[XB_XGEN(b.x)], 1u);
            asm volatile("s_waitcnt vmcnt(0)" ::: "memory");
        } else {
            XB_SPIN(xb_ld(&bar[XB_XGEN(b.x)]) == gen, bar);
            __builtin_amdgcn_fence(__ATOMIC_ACQUIRE, "agent");
            asm volatile("s_waitcnt vmcnt(0)" ::: "memory");
        }
    }
    __syncthreads();
}

__device__ __forceinline__ void phase_attn(int b, unsigned char* ws, unsigned char* lds, int wave) {
    att::Seam S; att::BlockRef cur, nxt; int n = 0;
    if (get_attn(b, 0, ws, cur)) {
        cur.jlo = compute_jlo(cur, (char*)lds, wave);
        att::prime(cur, (char*)lds, S, wave);
        for (;;) { const bool more = get_attn(b, n + 1, ws, nxt); if (!more) nxt = cur;
#ifdef PROBE_DUPFOX
            if (more && nxt.P0 < SEQ) nxt.jlo = cur.jlo;
#endif
            att::block(cur, nxt, (char*)lds, S, wave);
            if (!more) break; cur = nxt; ++n; }
    }
    asm volatile("s_waitcnt vmcnt(0)" ::: "memory");
    __syncthreads();
}
__device__ __forceinline__ void phase_conv(int b, unsigned char* ws, unsigned char* lds, int wave) {
    const float* conv_w = (const float*)lds_ptr(lds, 6); const float* conv_b = (const float*)lds_ptr(lds, 7); const float* conv_ln_g = (const float*)lds_ptr(lds, 8); const float* conv_ln_b = (const float*)lds_ptr(lds, 9);
    conv_item(b * 32, (const bf16_t*)(ws + WS_P), conv_w, conv_b, conv_ln_g, conv_ln_b, (const bf16_t*)(ws + WS_WPW), (bf16_t*)(ws + WS_Y), (char*)lds, wave);
}
#ifdef DUP_P3
#define P3_SS_SCALE 0.5f
#else
#define P3_SS_SCALE 1.f
#endif
struct Args { const float* in[14]; float* out; unsigned char* ws; int ph_lo, ph_hi; };
__global__ void __launch_bounds__(512, 2) fwd_kernel(Args a) {
    extern __shared__ __attribute__((aligned(16))) unsigned char lds[];
    if (a.ph_hi > 1000) { cg::grid_group grid = cg::this_grid(); grid.sync(); }
    const int wave = __builtin_amdgcn_readfirstlane((int)(threadIdx.x >> 6));
#define lane lane_id()
#define tid (wave * 64 + lane_id())
    const int G = gridDim.x, b = blockIdx.x;
    unsigned char* ws = a.ws;
    if (threadIdx.x < 14) ((const float**)(lds + 146944))[threadIdx.x] = a.in[threadIdx.x];
    if (threadIdx.x < 2) ((unsigned*)(lds + 146944 + 128))[threadIdx.x] = 0u;
    __syncthreads();
#define ARGP(k) ((const float*)lds_ptr(lds, (k)))
    XcdBarrier bar = xcd_barrier_post((unsigned*)(ws + WS_BAR), (volatile LAS unsigned*)(lds + 146944 + 128), wave == 0 && lane_id() == 0);
    const int lo = a.ph_lo, hi = a.ph_hi;
#ifdef DBG_PHASE
    unsigned long long tstamp[6]; tstamp[0] = __builtin_amdgcn_s_memrealtime();
#define STAMP(k) tstamp[k] = __builtin_amdgcn_s_memrealtime()
#else
#define STAMP(k)
#endif
#define IN(k) (lo <= (k) && (k) < hi)
#define BOTH(k) (IN(k) && IN((k) + 1))

#ifndef SKIP_P0
#ifdef DUP_P0
    for (int rep_ = 0; rep_ < 2; ++rep_)
#endif
    if (IN(0)) {
        const float* x = ARGP(0); const float* mem = ARGP(1); const float* norm_g = ARGP(2); const float* mem_norm_g = ARGP(3); const float* w_in = ARGP(4); const float* b_f = ARGP(5);
        const float* w_conv_pw = ARGP(10); const float* w_mem_kv = ARGP(11); const float* w_out = ARGP(12);
        float* ss = (float*)(ws + WS_SS);
        for (int i = b * 512 + tid; i < SEQ; i += G * 512) ss[i] = 0.f;
        { float* qn = (float*)(ws + WS_QN2); for (int i = b * 512 + tid; i < 16 * SEQ; i += G * 512) qn[i] = 0.f; }
        float* wf = (float*)(lds + 73728);
        f32x4 wfr[8];
#pragma unroll
        for (int q = 0; q < 8; ++q) { const int idx = tid + q * 512, k = idx >> 1, half = idx & 1; wfr[q] = *(const f32x4*)(w_in + (size_t)k * DIN + FCOL + half * 4); }
        const int gw = b * 8 + wave, NGW = G * 8;
        bf16_t* XB = (bf16_t*)(ws + WS_A); bf16_t* MEMN = (bf16_t*)(ws + WS_MEMN); float* LOGF = (float*)(ws + WS_LOGF);
#ifndef SKIP_TR
        transposes(0, 32 * (NP / 32) + 32 * 32, gw, NGW, w_in, w_mem_kv, w_out, w_conv_pw, ws, (float*)(lds + wave * 8448), lane);
#endif
#pragma unroll
        for (int q = 0; q < 8; ++q) { const int idx = tid + q * 512, k = idx >> 1, half = idx & 1, j = k >> 8, l = (k >> 2) & 63, i = k & 3;
            *(f32x4*)(wf + ((((j * 4 + i) * 2 + half) * 64 + l) << 2)) = wfr[q]; }
        __syncthreads();
#ifndef SKIP_ROWS
        {   f32x4* rowbuf = (f32x4*)(lds + wave * 8448);
            f32x4 gv[8], r0[8], r1[8], r2[8], r3[8];
            for (int m0 = gw * 4; m0 < SEQ; m0 += NGW * 4) {
                row_load(r0, x + (size_t)m0 * DM, lane); row_load(r1, x + (size_t)(m0 + 1) * DM, lane); row_load(r2, x + (size_t)(m0 + 2) * DM, lane); row_load(r3, x + (size_t)(m0 + 3) * DM, lane);
                row_load(gv, norm_g, lane);
                norm_row(r0, gv, XB + (size_t)m0 * DM, lane, wf, rowbuf, b_f, LOGF + m0);
                norm_row(r1, gv, XB + (size_t)(m0 + 1) * DM, lane, wf, rowbuf, b_f, LOGF + m0 + 1);
                norm_row(r2, gv, XB + (size_t)(m0 + 2) * DM, lane, wf, rowbuf, b_f, LOGF + m0 + 2);
                norm_row(r3, gv, XB + (size_t)(m0 + 3) * DM, lane, wf, rowbuf, b_f, LOGF + m0 + 3); }
            if (gw < MEMLEN) { row_load(gv, mem_norm_g, lane); row_load(r0, mem + (size_t)gw * DM, lane); norm_row(r0, gv, MEMN + (size_t)gw * DM, lane, nullptr, rowbuf, nullptr, nullptr); }
        }
#endif
#ifdef DBG_PHASE
        tstamp[5] = __builtin_amdgcn_s_memrealtime();
#endif
    }
#endif
    if (BOTH(0)) xcd_barrier(bar, wave == 0 && lane_id() == 0);
#ifdef PROBE_XBAR
    for (int q_ = 0; q_ < 4; ++q_) xcd_barrier(bar, wave == 0 && lane_id() == 0);
#endif
    STAMP(1);

#ifndef SKIP_P1
    if (IN(1)) {
        pg8::Gemm g{(const pg8::bf16_t*)(ws + WS_A), (const pg8::bf16_t*)(ws + WS_B), SEQ + 256, NP + 1024, DM};
        { Sched1 S{G, b, 3}; Epi1 E{(bf16_t*)(ws + WS_P), (bf16_t*)(ws + WS_MKV), (float*)(ws + WS_QN2), (bf16_t*)(ws + WS_KVH)};
          pg8::gemm_phase<Epi1, Sched1, true, false>((LAS unsigned char*)lds, g, S, E, wave); }
        if (b < 136) { SchedTail S{b}; Epi1H E{(bf16_t*)(ws + WS_P), (bf16_t*)(ws + WS_MKV), (float*)(ws + WS_QN2), (bf16_t*)(ws + WS_KVH)};
          pg8::gemm_phase<Epi1H, SchedTail, true, true, true>((LAS unsigned char*)lds, g, S, E, wave); }
        else {
            const int nidle = G - 136, gwi = (b - 136) * 8 + wave;
            __syncthreads();
            transposes(32 * (NP / 32) + 32 * 32, 32 * (NP / 32) + 32 * 32 + 32 * 64 + 8 * 16, gwi, nidle * 8, ARGP(4), ARGP(11), ARGP(12), ARGP(10), ws, (float*)(lds + wave * 8448), lane);
            __syncthreads();
            if (b >= 248) {
                const int hb = b - 248;
                const float* lf = (const float*)(ws + WS_LOGF) + (size_t)hb * SEQ; float* cs = (float*)(ws + WS_CS) + (size_t)hb * SEQ; float* wt = (float*)lds;
                f32x4 v[4]; float run = 0.f;
    #pragma unroll
                for (int j = 0; j < 4; ++j) { v[j] = *(const f32x4*)(lf + tid * 16 + j * 4);
                    v[j].x += run; v[j].y += v[j].x; v[j].z += v[j].y; v[j].w += v[j].z; run = v[j].w; }
                float inc = run;
    #pragma unroll
                for (int o = 1; o < 64; o <<= 1) { const float t = __shfl_up(inc, o); if (lane >= o) inc += t; }
                if (lane == 63) wt[wave] = inc;
                __syncthreads();
                float off = inc - run;
                for (int wv = 0; wv < wave; ++wv) off += wt[wv];
    #pragma unroll
                for (int j = 0; j < 4; ++j) *(f32x4*)(cs + tid * 16 + j * 4) = v[j] + off;
                __syncthreads();
            }
        }
#ifdef DUP_P1
        pg8::gemm_phase<Epi1, Sched1, true, true>((LAS unsigned char*)lds, g, S, E, wave);
#endif
    }
#endif
    if (BOTH(1)) xcd_barrier(bar, wave == 0 && lane_id() == 0);
    STAMP(2);

#ifndef SKIP_P2
    if (IN(2)) {
#ifndef SKIP_ATT
#ifdef DUP_ATT
#pragma unroll 1
        for (int rep_ = 0; rep_ < 2; ++rep_)
#endif
        phase_attn(b, ws, lds, wave);
#endif
#ifndef SKIP_CONV
        phase_conv(b, ws, lds, wave);
#ifdef DUP_CONV
        phase_conv(b, ws, lds, wave);
#endif
#endif
    }
#endif
    if (BOTH(2)) xcd_barrier(bar, wave == 0 && lane_id() == 0);
    STAMP(3);

#ifndef SKIP_P3
    if (IN(3)) {
        pg8::Gemm g{(const pg8::bf16_t*)(ws + WS_Y), (const pg8::bf16_t*)(ws + WS_WOUT), SEQ, DM, DM};
        pg8::StaticOrder S; S.init(SEQ, DM, G, b); Epi2 E{ARGP(0), a.out, (float*)(ws + WS_SS), ARGP(13), (unsigned*)(ws + WS_BAR + 16384)};
        pg8::gemm_phase<Epi2, pg8::StaticOrder, false, false>((LAS unsigned char*)lds, g, S, E, wave);
#ifdef DUP_P3_DISABLED
        pg8::gemm_phase<Epi2, pg8::StaticOrder, true, true>((LAS unsigned char*)lds, g, S, E, wave);
#endif
    }
#endif
#ifdef DBG_PHASE
    STAMP(4);
    __syncthreads();
    if (b == 0 && tid == 0) { float code = 0.f;
        if ((float)(tstamp[5] - tstamp[0]) * 0.01f > (float)DBG_T0) code += 1000.f;
        if ((float)(tstamp[5] - tstamp[0]) * 0.01f > (float)DBG_T1) code += 2000.f;
        if ((float)(tstamp[1] - tstamp[0]) * 0.01f > (float)DBG_T2) code += 4000.f;
        if ((float)(tstamp[1] - tstamp[0]) * 0.01f > (float)DBG_T3) code += 8000.f;
        if (code > 0.f) a.out[0] = code; }
#endif
#undef IN
#undef BOTH
#undef lane
#undef tid
}

#ifndef PH_LO
#define PH_LO 0
#endif
#ifndef PH_HI
#define PH_HI 5
#endif
#ifndef N_LAUNCHES
#define N_LAUNCHES 1
#endif
extern "C" void kernel_launch(void* const* d_in, const int* in_sizes, int n_in, void* d_out, int out_size, void* d_ws, size_t ws_size, hipStream_t stream) {
    static int grid = 0;
    if (grid == 0) {
        if (n_in != 14 || out_size != SEQ * DM || ws_size < WS_END) { fprintf(stderr, "kernel_launch: unexpected shapes (n_in %d out %d ws %zu)\n", n_in, out_size, ws_size); grid = -1; return; }
        int dev = 0, cus = 0, per_cu = 0;
        (void)hipGetDevice(&dev); (void)hipDeviceGetAttribute(&cus, hipDeviceAttributeMultiprocessorCount, dev);
        if (hipFuncSetAttribute((const void*)fwd_kernel, hipFuncAttributeMaxDynamicSharedMemorySize, LDS_BYTES) != hipSuccess) { fprintf(stderr, "kernel_launch: hipFuncSetAttribute failed\n"); grid = -1; return; }
        if (hipOccupancyMaxActiveBlocksPerMultiprocessor(&per_cu, (const void*)fwd_kernel, 512, LDS_BYTES) != hipSuccess || per_cu < 1) per_cu = 1;
        (void)hipGetLastError();
        if (cus <= 0) cus = 256;
        grid = cus * per_cu; if (grid > 256) grid = 256;
        if (grid != 256) { fprintf(stderr, "kernel_launch: this kernel needs a 256-workgroup cooperative grid (got %d)\n", grid); grid = -1; return; }
    }
    if (grid < 0) return;
    if (hipMemsetAsync((char*)d_ws + WS_BAR, 0, 16384 + 32 * 256, stream) != hipSuccess) { fprintf(stderr, "kernel_launch: memset failed\n"); return; }
    Args a{};
    for (int i = 0; i < 14; ++i) a.in[i] = (const float*)d_in[i];
    a.out = (float*)d_out; a.ws = (unsigned char*)d_ws;
    for (int li = 0; li < N_LAUNCHES; ++li) {
        if (N_LAUNCHES == 1) { a.ph_lo = PH_LO; a.ph_hi = PH_HI > 4 ? 4 : PH_HI; } else { a.ph_lo = li; a.ph_hi = li + 1; }
        void* args[] = {&a};
        hipError_t e = hipLaunchCooperativeKernel((const void*)fwd_kernel, dim3(grid), dim3(512), args, LDS_BYTES, stream);
        if (e != hipSuccess) { fprintf(stderr, "kernel_launch: cooperative launch failed: %s (grid %d)\n", hipGetErrorString(e), grid); break; }
    }
}
```

```cpp
#include <hip/hip_runtime.h>
#include <hip/hip_cooperative_groups.h>
#include <cstdio>
#include <cstdint>
namespace cg = cooperative_groups;

namespace pg8 {
#define PG8_LAS __attribute__((address_space(3)))
typedef unsigned short bf16_t;
typedef short bf16x8 __attribute__((ext_vector_type(8)));
typedef float f32x4 __attribute__((ext_vector_type(4)));
typedef unsigned u32x4 __attribute__((ext_vector_type(4)));
constexpr int BM = 256, BK = 64, HALF = 128, HTB = HALF * BK * 2  , STAGE_BYTES = 8 * HTB, NXCD = 8, WGM = 8;

__host__ __device__ __forceinline__ int lds_byte(int r, int c) { const int st = (r >> 4) * 2 + (c >> 5), rr = r & 15, cc = c & 31, ob = rr * 64 + cc * 2; return st * 1024 + (ob ^ (((ob >> 9) & 1) << 5)); }
__host__ __device__ __forceinline__ void stage_rc(int b, int& R, int& C) { const int st = b / 1024, sb = b % 1024, swz = sb ^ (((sb >> 9) & 1) << 5); R = (st >> 1) * 16 + swz / 64; C = (st & 1) * 32 + (swz % 64) / 2; }
__host__ __device__ __forceinline__ int perm32(int rho) { const int n = rho >> 4, i = rho & 15; return 8 * (i >> 2) + 4 * n + (i & 3); }

struct Unit { int pm, pn; };
struct Gemm { const bf16_t* A; const bf16_t* Bt; int M, N, K; };

struct StaticOrder {
    int nM, nN, nwg, G, c;
    __host__ __device__ void init(int M, int N, int G_, int c_) { nM = M / BM; nN = N / BM; nwg = nM * nN; G = G_; c = c_; }
    __host__ __device__ bool next(int i, Unit& u) const {
        const long L = (long)i * G + c; if (L >= nwg) return false;
        int wgid = (int)L; { const int q = nwg / NXCD, r = nwg % NXCD, xcd = wgid % NXCD, off = wgid / NXCD; wgid = (xcd < r ? xcd * (q + 1) : r * (q + 1) + (xcd - r) * q) + off; }
        const int nig = WGM * nN, gid = wgid / nig, fm = gid * WGM, gsz = (nM - fm) < WGM ? (nM - fm) : WGM;
        u.pm = fm + ((wgid % nig) % gsz); u.pn = (wgid % nig) / gsz; return true;
    }
    __device__ __forceinline__ void a_ready(const Unit&) const {}
    __device__ __forceinline__ void done(const Unit&) const {}
};

__device__ __forceinline__ unsigned cvt_pk_bf16(float lo, float hi) { unsigned r; asm volatile("v_cvt_pk_bf16_f32 %0, %1, %2" : "=v"(r) : "v"(lo), "v"(hi)); return r; }
typedef float f32x2 __attribute__((ext_vector_type(2)));
template <class Epi, class Sched, bool ALIGN_EPI = false, bool SP2 = false, bool HALF_M = false>
__device__ __forceinline__ void gemm_phase(PG8_LAS unsigned char* lds, const Gemm g, const Sched& S, const Epi& E, const int wv_) {
    const int wid = wv_, lane = (int)__builtin_amdgcn_mbcnt_hi(~0u, __builtin_amdgcn_mbcnt_lo(~0u, 0u)), tid = wid * 64 + lane, wr = wid >> 2, wc = wid & 3, fr = lane & 15, fq = lane >> 4;
    const int K = g.K, nt = K / BK;
    unsigned voffA[2], voffB[2];
#pragma unroll
    for (int i = 0; i < 2; ++i) { int R, C; stage_rc(tid * 16 + i * 8192, R, C); const int Rb = Epi::PERM ? ((R & ~31) + perm32(R & 31)) : R;
        voffA[i] = (unsigned)(R * K + C) * 2u; voffB[i] = (unsigned)(Rb * K + C) * 2u; }
    const size_t kstep = (size_t)(BK * 2);
    const size_t hstep = (size_t)HALF * K * 2;
    const size_t tstep = 2 * hstep;
    const size_t tstepA = HALF_M ? hstep : tstep;
    const unsigned ldsw = (unsigned)wid * 1024u;
    const int aoff = lds_byte(wr * 64 + fr, fq * 8), boff = lds_byte(wc * 32 + fr, fq * 8);
#define PG8_SA(b, h) (((b) * 2 + (h)) * HTB)
#define PG8_SB(b, h) ((4 + (b) * 2 + (h)) * HTB)
#define PG8_STAGE(bufoff, gbase, voff) do { _Pragma("unroll") for (int _i = 0; _i < 2; ++_i) \
        __builtin_amdgcn_global_load_lds((const unsigned*)((const char*)(gbase) + (voff)[_i]), (PG8_LAS unsigned*)(lds + (bufoff) + ldsw + _i * 8192), 16, 0, 0); } while (0)
#define PG8_LDA(dst, b, h) do { _Pragma("unroll") for (int m = 0; m < 4; ++m) _Pragma("unroll") for (int k = 0; k < 2; ++k) dst[m][k] = *(const PG8_LAS bf16x8*)(lds + PG8_SA(b, h) + aoff + m * 2048 + k * 1024); } while (0)
#define PG8_LDB(dst, b, h) do { _Pragma("unroll") for (int n = 0; n < 2; ++n) _Pragma("unroll") for (int k = 0; k < 2; ++k) dst[n][k] = *(const PG8_LAS bf16x8*)(lds + PG8_SB(b, h) + boff + n * 2048 + k * 1024); } while (0)
#define PG8_MMA(ai, bj, At, Bt) do { __builtin_amdgcn_s_setprio(1); _Pragma("unroll") for (int m = 0; m < 4; ++m) _Pragma("unroll") for (int n = 0; n < 2; ++n) _Pragma("unroll") for (int k = 0; k < 2; ++k) \
        acc[ai][bj][m][n] = __builtin_amdgcn_mfma_f32_16x16x32_bf16(Bt[n][k], At[m][k], acc[ai][bj][m][n], 0, 0, 0); __builtin_amdgcn_s_setprio(0); } while (0)
#define PG8_WAIT_V(n) asm volatile("s_waitcnt vmcnt(" #n ")" ::: "memory")
#define PG8_WAIT_L(n) asm volatile("s_waitcnt lgkmcnt(" #n ")" ::: "memory")
#define PG8_BAR __builtin_amdgcn_s_barrier()
#define PG8_SCHED __builtin_amdgcn_sched_barrier(0)
    Unit cur, nxt; int ui = 0;
    if (!S.next(0, cur)) return;
    f32x4 acc[2][2][4][2];
#pragma unroll
    for (int a = 0; a < 2; ++a)
#pragma unroll
        for (int b = 0; b < 2; ++b)
#pragma unroll
            for (int m = 0; m < 4; ++m)
#pragma unroll
                for (int n = 0; n < 2; ++n) acc[a][b][m][n] = (f32x4){0.f, 0.f, 0.f, 0.f};
    bf16x8 At[4][2], B0[2][2], B1[2][2];
    const char* cA = (const char*)g.A + (size_t)cur.pm * tstepA; const char* cB = (const char*)g.Bt + (size_t)cur.pn * tstep;
    S.a_ready(cur);
    if constexpr (SP2) {
        PG8_STAGE(PG8_SB(0, 0), cB, voffB); PG8_STAGE(PG8_SB(0, 1), cB + hstep, voffB); PG8_STAGE(PG8_SA(0, 0), cA, voffA); PG8_STAGE(PG8_SA(0, 1), cA + hstep, voffA);
        if (wr == 1) PG8_BAR;
        PG8_WAIT_V(2); PG8_BAR;
        PG8_STAGE(PG8_SB(1, 0), cB + kstep, voffB); PG8_STAGE(PG8_SA(1, 0), cA + kstep, voffA); PG8_STAGE(PG8_SB(1, 1), cB + hstep + kstep, voffB);
        PG8_WAIT_V(6); PG8_BAR;
    } else {
        PG8_STAGE(PG8_SB(0, 0), cB, voffB); PG8_STAGE(PG8_SA(0, 0), cA, voffA); PG8_STAGE(PG8_SB(0, 1), cB + hstep, voffB); PG8_STAGE(PG8_SA(0, 1), cA + hstep, voffA);
        if (wr == 1) PG8_BAR;
        PG8_WAIT_V(4); PG8_BAR;
        PG8_STAGE(PG8_SB(1, 0), cB + kstep, voffB); PG8_STAGE(PG8_SA(1, 0), cA + kstep, voffA); PG8_STAGE(PG8_SB(1, 1), cB + hstep + kstep, voffB);
        PG8_WAIT_V(6); PG8_BAR;
    }
    for (;;) {
        const bool has_next = S.next(ui + 1, nxt);
        const char* nA = has_next ? (const char*)g.A + (size_t)nxt.pm * tstepA : cA; const char* nB = has_next ? (const char*)g.Bt + (size_t)nxt.pn * tstep : cB;
        for (int t = 0; t < nt; t += 2) {
            const bool last = (t == nt - 2);
            const char* a1 = cA + (size_t)(t + 1) * kstep;
            const char* a2 = last ? nA : cA + (size_t)(t + 2) * kstep; const char* b2 = last ? nB : cB + (size_t)(t + 2) * kstep;
            const char* a3 = a2 + kstep; const char* b3 = b2 + kstep;
            if (last && has_next) S.a_ready(nxt);
            if constexpr (SP2) {
            PG8_LDB(B0, 0, 0); PG8_LDB(B1, 0, 1); PG8_SCHED; PG8_LDA(At, 0, 0); PG8_STAGE(PG8_SA(1, 1), a1 + hstep, voffA);
            PG8_WAIT_V(8); PG8_WAIT_L(0); PG8_BAR; PG8_MMA(0, 0, At, B0); PG8_MMA(0, 1, At, B1); PG8_BAR; PG8_SCHED;
            PG8_LDA(At, 0, 1); PG8_STAGE(PG8_SB(0, 0), b2, voffB); PG8_STAGE(PG8_SB(0, 1), b2 + hstep, voffB); PG8_STAGE(PG8_SA(0, 0), a2, voffA);
            PG8_WAIT_V(8); PG8_WAIT_L(0); PG8_BAR; if constexpr (!HALF_M) { PG8_MMA(1, 0, At, B0); PG8_MMA(1, 1, At, B1); } PG8_BAR; PG8_SCHED;
            PG8_LDB(B0, 1, 0); PG8_LDB(B1, 1, 1); PG8_SCHED; PG8_LDA(At, 1, 0); PG8_STAGE(PG8_SA(0, 1), a2 + hstep, voffA);
            PG8_WAIT_V(8); PG8_WAIT_L(0); PG8_BAR; PG8_MMA(0, 0, At, B0); PG8_MMA(0, 1, At, B1); PG8_BAR; PG8_SCHED;
            PG8_LDA(At, 1, 1); PG8_STAGE(PG8_SB(1, 0), b3, voffB); PG8_STAGE(PG8_SB(1, 1), b3 + hstep, voffB); PG8_STAGE(PG8_SA(1, 0), a3, voffA);
            PG8_WAIT_V(8); PG8_WAIT_L(0); PG8_BAR; if constexpr (!HALF_M) { PG8_MMA(1, 0, At, B0); PG8_MMA(1, 1, At, B1); } PG8_BAR; PG8_SCHED;
            } else {
            PG8_LDB(B0, 0, 0); PG8_SCHED; PG8_LDA(At, 0, 0); PG8_STAGE(PG8_SA(1, 1), a1 + hstep, voffA);
            PG8_WAIT_L(8); PG8_BAR; PG8_WAIT_L(0); PG8_MMA(0, 0, At, B0); PG8_BAR; PG8_SCHED;
            PG8_LDB(B1, 0, 1); PG8_STAGE(PG8_SB(0, 0), b2, voffB);
            PG8_BAR; PG8_WAIT_L(0); PG8_MMA(0, 1, At, B1); PG8_BAR;
            PG8_LDA(At, 0, 1); PG8_STAGE(PG8_SA(0, 0), a2, voffA);
            PG8_BAR; PG8_WAIT_L(0); PG8_MMA(1, 0, At, B0); PG8_BAR; PG8_SCHED;
            PG8_STAGE(PG8_SB(0, 1), b2 + hstep, voffB);
            PG8_WAIT_V(6); PG8_BAR; PG8_MMA(1, 1, At, B1); PG8_BAR;
            PG8_LDB(B0, 1, 0); PG8_SCHED; PG8_LDA(At, 1, 0); PG8_STAGE(PG8_SA(0, 1), a2 + hstep, voffA);
            PG8_WAIT_L(8); PG8_BAR; PG8_WAIT_L(0); PG8_MMA(0, 0, At, B0); PG8_BAR; PG8_SCHED;
            PG8_LDB(B1, 1, 1); PG8_STAGE(PG8_SB(1, 0), b3, voffB);
            PG8_BAR; PG8_WAIT_L(0); PG8_MMA(0, 1, At, B1); PG8_BAR;
            PG8_LDA(At, 1, 1); PG8_STAGE(PG8_SA(1, 0), a3, voffA);
            PG8_BAR; PG8_WAIT_L(0); PG8_MMA(1, 0, At, B0); PG8_BAR; PG8_SCHED;
            PG8_STAGE(PG8_SB(1, 1), b3 + hstep, voffB);
            PG8_WAIT_V(6); PG8_BAR; PG8_MMA(1, 1, At, B1); PG8_BAR;
            }
        }
        if constexpr (ALIGN_EPI) { if (wr == 0) PG8_BAR; }
        if constexpr (!Epi::AFTER_DRAIN) { E(acc, cur, wr, wc, fr, fq); S.done(cur); }
        if (!has_next) break;
#pragma unroll
        for (int a = 0; a < 2; ++a)
#pragma unroll
            for (int b = 0; b < 2; ++b)
#pragma unroll
                for (int m = 0; m < 4; ++m)
#pragma unroll
                    for (int n = 0; n < 2; ++n) acc[a][b][m][n] = (f32x4){0.f, 0.f, 0.f, 0.f};
        cur = nxt; cA = nA; cB = nB; ++ui;
        if constexpr (ALIGN_EPI) { if (wr == 1) PG8_BAR; }
    }
    PG8_WAIT_V(0);
    if constexpr (!ALIGN_EPI) { if (wr == 0) PG8_BAR; }
    PG8_BAR;
    if constexpr (Epi::AFTER_DRAIN) { E.fused(acc, cur, wr, wc, fr, fq, lds, wid, lane); S.done(cur); }
#undef PG8_SA
#undef PG8_SB
#undef PG8_STAGE
#undef PG8_LDA
#undef PG8_LDB
#undef PG8_MMA
#undef PG8_WAIT_V
#undef PG8_WAIT_L
#undef PG8_BAR
#undef PG8_SCHED
}
}

#define LAS __attribute__((address_space(3)))
typedef unsigned short bf16_t;
typedef short bf16x8 __attribute__((ext_vector_type(8)));
typedef short s16x4 __attribute__((ext_vector_type(4)));
typedef float f32x4 __attribute__((ext_vector_type(4)));
typedef float f32x16 __attribute__((ext_vector_type(16)));
typedef unsigned u32x4 __attribute__((ext_vector_type(4)));
typedef unsigned u32x2 __attribute__((ext_vector_type(2)));

constexpr int SEQ = 8192, DM = 2048, DIN = 6664, NP = 6656, MEMLEN = 256, FCOL = 4608;
constexpr int C_CVA = 0, C_CVB = 512, C_CVG = 1024, C_FQ = 1536, C_FK = 2560, C_FV = 3584, C_FG = 4608, C_MQ = 5632, C_MG = 6144;
constexpr int Y_CONV = 0, Y_FOX = 512, Y_MEM = 1536;
constexpr float EPS = 1e-6f;
constexpr size_t MiB = 1u << 20;
constexpr size_t WS_BAR = 64 * 1024;
constexpr size_t WS_SS = 0, WS_LOGF = 1 * MiB, WS_CS = 1 * MiB + 256 * 1024, WS_QN2 = 1 * MiB + 512 * 1024, WS_KN2 = 1 * MiB + 768 * 1024;
constexpr size_t WS_A = 2 * MiB;
constexpr size_t WS_MEMN = WS_A + 32 * MiB;
constexpr size_t WS_B = 36 * MiB;
constexpr size_t WS_WKV = WS_B + 26 * MiB;
constexpr size_t WS_WOUT = 66 * MiB, WS_WPW = 74 * MiB, WS_MKV = 75 * MiB, WS_P = 76 * MiB, WS_Y = 180 * MiB, WS_KVH = 212 * MiB, WS_END = 244 * MiB;
constexpr int LDS_BYTES = 147456;

__device__ __forceinline__ unsigned pk2(float lo, float hi) { unsigned r; asm("v_cvt_pk_bf16_f32 %0, %1, %2" : "=v"(r) : "v"(lo), "v"(hi)); return r; }
__device__ __forceinline__ unsigned f2bf(float f) { return pk2(f, f) & 0xffffu; }
__device__ __forceinline__ float bf2f(unsigned short b) { return __builtin_bit_cast(float, (unsigned)b << 16); }
__device__ __forceinline__ float sigmoidf_(float x) { return __builtin_amdgcn_rcpf(1.f + __expf(-x)); }
__device__ __forceinline__ float wave_sum(float v) {
#define DPP_(x, ctrl, rm) __builtin_bit_cast(float, __builtin_amdgcn_update_dpp(0, __builtin_bit_cast(int, (x)), (ctrl), (rm), 0xF, false))
    v += DPP_(v, 0xB1, 0xF);
    v += DPP_(v, 0x4E, 0xF);
    v += DPP_(v, 0x141, 0xF);
    v += DPP_(v, 0x140, 0xF);
    v += DPP_(v, 0x142, 0xA);
    v += DPP_(v, 0x143, 0xC);
#undef DPP_
    return __builtin_bit_cast(float, __builtin_amdgcn_readlane(__builtin_bit_cast(int, v), 63));
}
#define LD8(p) (*reinterpret_cast<const bf16x8*>(p))
__device__ __forceinline__ int lane_id() { return (int)__builtin_amdgcn_mbcnt_hi(~0u, __builtin_amdgcn_mbcnt_lo(~0u, 0u)); }

struct Sched1 {
    int G, c, nr;
    __device__ __forceinline__ bool next(int i, pg8::Unit& u) const {
        if (i >= nr) return false;
        const int L = i * G + c; if (L >= 836) return false;
        if (L >= 832) { u.pm = 32; u.pn = 26 + (L - 832); return true; }
        constexpr int nM = 32, nN = 26, nwg = 832, NX = 8, WGM = 8;
        int wgid = L; { const int q = nwg / NX, r = nwg % NX, xcd = wgid % NX, off = wgid / NX; wgid = (xcd < r ? xcd * (q + 1) : r * (q + 1) + (xcd - r) * q) + off; }
        const int nig = WGM * nN, gid = wgid / nig, fm = gid * WGM, gsz = (nM - fm) < WGM ? (nM - fm) : WGM;
        u.pm = fm + ((wgid % nig) % gsz); u.pn = (wgid % nig) / gsz; return true;
    }
    __device__ __forceinline__ void a_ready(const pg8::Unit&) const {}
    __device__ __forceinline__ void done(const pg8::Unit&) const {}
};
struct Epi1 {
    static constexpr bool PERM = true, AFTER_DRAIN = false;
    bf16_t* P; bf16_t* MKV; float* QN2; bf16_t* KVH;
    __device__ __forceinline__ void operator()(const pg8::f32x4 (&acc)[2][2][4][2], const pg8::Unit& u, int wr, int wc, int fr, int fq) const {
        bf16_t* base; int ldc, colt, row0;
        size_t bjs = 128;
        if (u.pm == 32) { base = MKV; ldc = 1024; colt = (u.pn - 26) * 256; row0 = wr * 64 + fr; }
        else if (u.pn >= 10 && u.pn < 18) { base = KVH + (size_t)((u.pn - 10) * 2) * SEQ * 128; ldc = 128; colt = 0; row0 = u.pm * 256 + wr * 64 + fr; bjs = (size_t)SEQ * 128; }
        else { base = P; ldc = NP; colt = u.pn * 256; row0 = u.pm * 256 + wr * 64 + fr; }
        const int col0 = colt + wc * 32 + 8 * fq;
        if (u.pm != 32 && u.pn < 4) {
#pragma unroll
            for (int ai = 0; ai < 2; ++ai)
#pragma unroll
                for (int m = 0; m < 4; ++m) { bf16_t* rowp = base + (size_t)(row0 + ai * 128 + m * 16) * ldc + col0; float g8[8];
#pragma unroll
                    for (int n = 0; n < 2; ++n)
#pragma unroll
                        for (int e = 0; e < 4; ++e) g8[4 * n + e] = acc[ai][0][m][n][e] * sigmoidf_(acc[ai][1][m][n][e]);
                    u32x4 w; w.x = pg8::cvt_pk_bf16(g8[0], g8[1]); w.y = pg8::cvt_pk_bf16(g8[2], g8[3]); w.z = pg8::cvt_pk_bf16(g8[4], g8[5]); w.w = pg8::cvt_pk_bf16(g8[6], g8[7]);
                    *(u32x4*)rowp = w; }
            return;
        }
        const bool gate = u.pm != 32 && (u.pn == 4 || u.pn == 5 || (u.pn >= 18 && u.pn < 22) || u.pn == 24 || u.pn == 25);
#pragma unroll
        for (int ai = 0; ai < 2; ++ai)
#pragma unroll
            for (int m = 0; m < 4; ++m) { bf16_t* rowp = base + (size_t)(row0 + ai * 128 + m * 16) * ldc + col0;
#pragma unroll
                for (int bj = 0; bj < 2; ++bj) { pg8::f32x4 v0 = acc[ai][bj][m][0], v1 = acc[ai][bj][m][1];
                    if (gate) {
#pragma unroll
                        for (int e = 0; e < 4; ++e) { v0[e] = v0[e] * sigmoidf_(v0[e]); v1[e] = v1[e] * sigmoidf_(v1[e]); } }
                    u32x4 w; w.x = pg8::cvt_pk_bf16(v0[0], v0[1]); w.y = pg8::cvt_pk_bf16(v0[2], v0[3]); w.z = pg8::cvt_pk_bf16(v1[0], v1[1]); w.w = pg8::cvt_pk_bf16(v1[2], v1[3]);
                    *(u32x4*)(rowp + bj * bjs) = w; } }
        if (u.pm != 32 && u.pn >= 6 && u.pn < 14) {
            float* nb = QN2 + (size_t)((u.pn - 6) * 2) * SEQ;
#pragma unroll
            for (int ai = 0; ai < 2; ++ai)
#pragma unroll
                for (int m = 0; m < 4; ++m)
#pragma unroll
                    for (int bj = 0; bj < 2; ++bj) { const pg8::f32x4 v0 = acc[ai][bj][m][0], v1 = acc[ai][bj][m][1];
                        float q = (v0[0] * v0[0] + v0[1] * v0[1]) + (v0[2] * v0[2] + v0[3] * v0[3]) + (v1[0] * v1[0] + v1[1] * v1[1]) + (v1[2] * v1[2] + v1[3] * v1[3]);
                        q += __shfl_xor(q, 16); q += __shfl_xor(q, 32);
                        if (fq == 0) atomicAdd(nb + (size_t)bj * SEQ + row0 + ai * 128 + m * 16, q); }
        }
    }
};
struct SchedTail {
    int c;
    __device__ __forceinline__ bool next(int i, pg8::Unit& u) const {
        if (i != 0 || c >= 136) return false;
        Sched1 S1{256, 0, 4}; pg8::Unit f; S1.c = (c >> 1); if (!S1.next(3, f)) return false;
        u.pm = 2 * f.pm + (c & 1); u.pn = f.pn; return true;
    }
    __device__ __forceinline__ void a_ready(const pg8::Unit&) const {}
    __device__ __forceinline__ void done(const pg8::Unit&) const {}
};
struct Epi1H {
    static constexpr bool PERM = true, AFTER_DRAIN = false;
    bf16_t* P; bf16_t* MKV; float* QN2; bf16_t* KVH;
    __device__ __forceinline__ void operator()(const pg8::f32x4 (&acc)[2][2][4][2], const pg8::Unit& u, int wr, int wc, int fr, int fq) const {
        bf16_t* base; int ldc, colt, row0;
        size_t bjs = 128;
        if (u.pm >= 64) { base = MKV; ldc = 1024; colt = (u.pn - 26) * 256; row0 = (u.pm - 64) * 128 + wr * 64 + fr; }
        else if (u.pn >= 10 && u.pn < 18) { base = KVH + (size_t)((u.pn - 10) * 2) * SEQ * 128; ldc = 128; colt = 0; row0 = u.pm * 128 + wr * 64 + fr; bjs = (size_t)SEQ * 128; }
        else { base = P; ldc = NP; colt = u.pn * 256; row0 = u.pm * 128 + wr * 64 + fr; }
        const int col0 = colt + wc * 32 + 8 * fq;
        const bool gate = u.pm < 64 && (u.pn == 4 || u.pn == 5 || (u.pn >= 18 && u.pn < 22) || u.pn == 24 || u.pn == 25);
#pragma unroll
        for (int m = 0; m < 4; ++m) { bf16_t* rowp = base + (size_t)(row0 + m * 16) * ldc + col0;
#pragma unroll
            for (int bj = 0; bj < 2; ++bj) { pg8::f32x4 v0 = acc[0][bj][m][0], v1 = acc[0][bj][m][1];
                if (gate) {
#pragma unroll
                    for (int e = 0; e < 4; ++e) { v0[e] = v0[e] * sigmoidf_(v0[e]); v1[e] = v1[e] * sigmoidf_(v1[e]); } }
                u32x4 w; w.x = pg8::cvt_pk_bf16(v0[0], v0[1]); w.y = pg8::cvt_pk_bf16(v0[2], v0[3]); w.z = pg8::cvt_pk_bf16(v1[0], v1[1]); w.w = pg8::cvt_pk_bf16(v1[2], v1[3]);
                *(u32x4*)(rowp + bj * bjs) = w; } }
        if (u.pm < 64 && u.pn >= 6 && u.pn < 14) {
            float* nb = QN2 + (size_t)((u.pn - 6) * 2) * SEQ;
#pragma unroll
            for (int m = 0; m < 4; ++m)
#pragma unroll
                for (int bj = 0; bj < 2; ++bj) { const pg8::f32x4 v0 = acc[0][bj][m][0], v1 = acc[0][bj][m][1];
                    float q = (v0[0] * v0[0] + v0[1] * v0[1]) + (v0[2] * v0[2] + v0[3] * v0[3]) + (v1[0] * v1[0] + v1[1] * v1[1]) + (v1[2] * v1[2] + v1[3] * v1[3]);
                    q += __shfl_xor(q, 16); q += __shfl_xor(q, 32);
                    if (fq == 0) atomicAdd(nb + (size_t)bj * SEQ + row0 + m * 16, q); }
        }
    }
};
struct Epi2 {
    static constexpr bool PERM = false, AFTER_DRAIN = true;
    const float* x; float* out; float* ss; const float* fg; unsigned* pcnt;
    __device__ __forceinline__ void fused(pg8::f32x4 (&acc)[2][2][4][2], const pg8::Unit& u, int wr, int wc, int fr, int fq, PG8_LAS unsigned char* lds, int wid, int lane) const {
        const int col0 = u.pn * 256 + wc * 32 + 4 * fq;
#pragma unroll
        for (int ai = 0; ai < 2; ++ai)
#pragma unroll
            for (int m = 0; m < 4; ++m) { const int row = u.pm * 256 + ai * 128 + wr * 64 + m * 16 + fr; const size_t off = (size_t)row * DM + col0; float q = 0.f;
#pragma unroll
                for (int bj = 0; bj < 2; ++bj)
#pragma unroll
                    for (int n = 0; n < 2; ++n) { const f32x4 xv = *(const f32x4*)(x + off + bj * 128 + n * 16); const f32x4 o = xv + acc[ai][bj][m][n];
                        acc[ai][bj][m][n] = o; q += (o[0] * o[0] + o[1] * o[1]) + (o[2] * o[2] + o[3] * o[3]); }
                q += __shfl_xor(q, 16); q += __shfl_xor(q, 32);
                if (fq == 0) atomicAdd(ss + row, q);
                if (m == 3) asm volatile("" ::: "memory"); }
        asm volatile("s_waitcnt vmcnt(0)" ::: "memory");
        unsigned* cnt = pcnt + 64 * u.pm;
        if (lane == 0) __hip_atomic_fetch_add(cnt, 1u, __ATOMIC_RELAXED, __HIP_MEMORY_SCOPE_AGENT);
        if (wid == 0 && lane == 0) { while (__hip_atomic_load(cnt, __ATOMIC_RELAXED, __HIP_MEMORY_SCOPE_AGENT) < 64u) __builtin_amdgcn_s_sleep(1); }
        __builtin_amdgcn_s_barrier();
        asm volatile("" ::: "memory");
        f32x4 gv[2][2];
#pragma unroll
        for (int bj = 0; bj < 2; ++bj)
#pragma unroll
            for (int n = 0; n < 2; ++n) gv[bj][n] = *(const f32x4*)(fg + col0 + bj * 128 + n * 16);
#pragma unroll
        for (int ai = 0; ai < 2; ++ai)
#pragma unroll
            for (int m = 0; m < 4; ++m) { const int row = u.pm * 256 + ai * 128 + wr * 64 + m * 16 + fr; const size_t off = (size_t)row * DM + col0;
                const float sc = rsqrtf(__hip_atomic_load(ss + row, __ATOMIC_RELAXED, __HIP_MEMORY_SCOPE_AGENT) * (1.f / DM) + EPS);
#pragma unroll
                for (int bj = 0; bj < 2; ++bj)
#pragma unroll
                    for (int n = 0; n < 2; ++n) *(f32x4*)(out + off + bj * 128 + n * 16) = acc[ai][bj][m][n] * sc * gv[bj][n]; }
    }
};

namespace att {
constexpr int D = 128, NW = 8, QBLK = 32, KVBLK = 64, QB = NW * QBLK;
constexpr int SHM_V = KVBLK * D * 2, SHM_K = KVBLK * D * 2;
constexpr int LDS_C = 2 * SHM_V + 2 * SHM_K + NW * 64 * 4;
constexpr int LDS_ATT = LDS_C + 8192 * 4;
constexpr float SCALE = 0.08838834764831845f, THR = 8.f;
constexpr unsigned WBIG = 0x40000000u;
#define KSWZ(row, colB) ((row) * 256 + ((colB) ^ (((row) & 7) << 4)))
#define SBAR() __builtin_amdgcn_sched_barrier(0)
__device__ __forceinline__ int v_st(int k, int c) { const int kk = (k & ~0xC) | ((k & 4) << 1) | ((k & 8) >> 1); return ((kk >> 3) * 4 + (c >> 5)) * 512 + ((kk & 7) * 32 + (c & 31)) * 2; }
__device__ __forceinline__ int v_rd_base(int lane) { return ((lane & 3) << 3) | (((lane >> 2) & 3) << 6) | (((lane >> 4) & 1) << 5) | (((lane >> 5) & 1) << 8); }
constexpr int v_rd_off(int d0, int ks, int half) { return d0 * 512 + ks * 4096 + half * 2048; }
__device__ __forceinline__ int crow(int r, int hi) { return (r & 3) + 8 * (r >> 2) + 4 * hi; }
__device__ __forceinline__ unsigned cvtpk(float lo, float hi) { unsigned r; asm volatile("v_cvt_pk_bf16_f32 %0, %1, %2" : "=v"(r) : "v"(lo), "v"(hi)); return r; }
__device__ __forceinline__ void mask_tile(f32x16& p0, f32x16& p1, int dq, unsigned W) {
    const float NEG = -__builtin_inff();
#pragma unroll
    for (int r = 0; r < 16; ++r) {
        const int c = (r & 3) + 8 * (r >> 2);
        if ((unsigned)(dq - c) >= W) p0[r] = NEG;
        if ((unsigned)(dq - c - 32) >= W) p1[r] = NEG;
    }
}
__device__ __forceinline__ void partialSM(f32x16& p0, f32x16& p1, float& m_reg, float& mn, float& alpha) {
    float pmax = p0[0];
#pragma unroll
    for (int r = 1; r < 16; ++r) pmax = fmaxf(pmax, p0[r]);
#pragma unroll
    for (int r = 0; r < 16; ++r) pmax = fmaxf(pmax, p1[r]);
    { auto rr = __builtin_amdgcn_permlane32_swap(__float_as_uint(pmax), __float_as_uint(pmax), false, false);
      pmax = fmaxf(__uint_as_float(rr[0]), __uint_as_float(rr[1])); }
    constexpr float C2 = 1.4426950408889634f * SCALE;
    if (__builtin_expect(__all((pmax - m_reg) * SCALE <= THR), 1)) { mn = m_reg; alpha = 1.f; }
    else { mn = fmaxf(m_reg, pmax); alpha = __builtin_amdgcn_exp2f((m_reg - mn) * C2); m_reg = mn; }
    const float mnL = -mn * C2;
#pragma unroll
    for (int r = 0; r < 16; ++r) p0[r] = fmaf(p0[r], C2, mnL);
#pragma unroll
    for (int r = 0; r < 16; ++r) p1[r] = fmaf(p1[r], C2, mnL);
#pragma unroll
    for (int r = 0; r < 16; ++r) p0[r] = __builtin_amdgcn_exp2f(p0[r]);
}
__device__ __forceinline__ void finishSM(f32x16& p0, f32x16& p1, float alpha, float& l_reg, bf16x8& pa0, bf16x8& pa1, bf16x8& pa2, bf16x8& pa3) {
#pragma unroll
    for (int r = 0; r < 16; ++r) p1[r] = __builtin_amdgcn_exp2f(p1[r]);
    float ps = 0;
#pragma unroll
    for (int r = 0; r < 16; ++r) ps += p0[r];
#pragma unroll
    for (int r = 0; r < 16; ++r) ps += p1[r];
    { auto rr = __builtin_amdgcn_permlane32_swap(__float_as_uint(ps), __float_as_uint(ps), false, false);
      ps = __uint_as_float(rr[0]) + __uint_as_float(rr[1]); }
    l_reg = l_reg * alpha + ps;
#define PK4(P, B_, OUT) do { unsigned a0 = cvtpk(P[B_+0], P[B_+1]), a1 = cvtpk(P[B_+2], P[B_+3]);                          \
        unsigned b0 = cvtpk(P[B_+4], P[B_+5]), b1 = cvtpk(P[B_+6], P[B_+7]);                                             \
        auto r0 = __builtin_amdgcn_permlane32_swap(a0, b0, false, false); auto r1 = __builtin_amdgcn_permlane32_swap(a1, b1, false, false); \
        u32x4 w = {r0[0], r1[0], r0[1], r1[1]}; OUT = *reinterpret_cast<bf16x8*>(&w); } while (0)
    PK4(p0, 0, pa0); PK4(p0, 8, pa1); PK4(p1, 0, pa2); PK4(p1, 8, pa3);
#undef PK4
}
template <int KB>
__device__ __forceinline__ void qkt(f32x16& p0, f32x16& p1, const char* K_lds, int r32, int hi, const bf16x8* qr, const float* cb, float cq) {
#ifdef ATT_NO_BIAS
    p0 = f32x16{}; p1 = f32x16{};
#else
#pragma unroll
    for (int g = 0; g < 4; ++g) { const f32x4 a = *(const f32x4*)(cb + 8 * g), b = *(const f32x4*)(cb + 32 + 8 * g);
#pragma unroll
        for (int j = 0; j < 4; ++j) { p0[4 * g + j] = cq - a[j]; p1[4 * g + j] = cq - b[j]; } }
#endif
    const char* kb[4];
#pragma unroll
    for (int dd = 0; dd < 4; ++dd) kb[dd] = K_lds + KB * SHM_K + KSWZ(r32, (dd * 16 + hi * 8) * 2);
#pragma unroll
    for (int d0 = 0; d0 < 8; ++d0) { const char* a = kb[d0 & 3] + (d0 >> 2) * 128;
        bf16x8 b0 = *reinterpret_cast<const bf16x8*>(a);
        bf16x8 b1 = *reinterpret_cast<const bf16x8*>(a + 32 * 256);
        p0 = __builtin_amdgcn_mfma_f32_32x32x16_bf16(b0, qr[d0], p0, 0, 0, 0);
        p1 = __builtin_amdgcn_mfma_f32_32x32x16_bf16(b1, qr[d0], p1, 0, 0, 0); }
}
template <int VB>
__device__ __forceinline__ void pv_tile(f32x16* o, int vb0, bf16x8 pa0, bf16x8 pa1, bf16x8 pa2, bf16x8 pa3) {
#define TRRD(dst, off) asm volatile("ds_read_b64_tr_b16 %0, %1 offset:%2" : "=&v"(dst) : "v"(vb0), "i"(off) : "memory")
#define PV_D0(d0) do { s16x4 l0, l1, l2, l3, h0, h1, h2, h3; constexpr int b_ = VB * SHM_V + v_rd_off(d0, 0, 0); \
        TRRD(l0, b_); TRRD(h0, b_ + 2048); TRRD(l1, b_ + 4096); TRRD(h1, b_ + 6144); TRRD(l2, b_ + 8192); TRRD(h2, b_ + 10240); TRRD(l3, b_ + 12288); TRRD(h3, b_ + 14336); \
        asm volatile("s_waitcnt lgkmcnt(0)" ::: "memory"); SBAR(); \
        o[d0] = __builtin_amdgcn_mfma_f32_32x32x16_bf16(pa0, (bf16x8){l0[0], l0[1], l0[2], l0[3], h0[0], h0[1], h0[2], h0[3]}, o[d0], 0, 0, 0);   \
        o[d0] = __builtin_amdgcn_mfma_f32_32x32x16_bf16(pa1, (bf16x8){l1[0], l1[1], l1[2], l1[3], h1[0], h1[1], h1[2], h1[3]}, o[d0], 0, 0, 0);   \
        o[d0] = __builtin_amdgcn_mfma_f32_32x32x16_bf16(pa2, (bf16x8){l2[0], l2[1], l2[2], l2[3], h2[0], h2[1], h2[2], h2[3]}, o[d0], 0, 0, 0);   \
        o[d0] = __builtin_amdgcn_mfma_f32_32x32x16_bf16(pa3, (bf16x8){l3[0], l3[1], l3[2], l3[3], h3[0], h3[1], h3[2], h3[3]}, o[d0], 0, 0, 0); } while (0)
    PV_D0(0); PV_D0(1); PV_D0(2); PV_D0(3);
#undef PV_D0
#undef TRRD
}
struct BlockRef { const bf16_t* Q; const bf16_t* K; const float* C; bf16_t* O; int voff, goff, P0, skv, pkv, jlo, c0i; };
struct Seam { bf16x8 qr[8]; bf16x8 st_v0, st_v1, st_k0, st_k1; };
#define VMW() asm volatile("s_waitcnt vmcnt(0)" ::: "memory")
#define VMWN(n) asm volatile("s_waitcnt vmcnt(%0)" :: "i"(n) : "memory")
#define SLOAD_H(Kp, Vp, pitch, k0, roff) do { const char* kb_ = (const char*)(Kp) + (size_t)(k0) * (size_t)(pitch) * 2; const char* vb_ = (const char*)(Vp) + (size_t)(k0) * (size_t)(pitch) * 2; \
        S.st_v0 = LD8(vb_ + (roff)); S.st_v1 = LD8(vb_ + (size_t)(pitch) * 64 + (roff)); S.st_k0 = LD8(kb_ + (roff)); S.st_k1 = LD8(kb_ + (size_t)(pitch) * 64 + (roff)); } while (0)
#define SWRITE_HK(bf) do { *(bf16x8*)(K_lds + (bf) * SHM_K + kws) = S.st_k0; *(bf16x8*)(K_lds + (bf) * SHM_K + kws + 32 * 256) = S.st_k1; } while (0)
#define SWRITE_HV(bf) do { *(bf16x8*)(V_lds + (bf) * SHM_V + vst0) = S.st_v0; *(bf16x8*)(V_lds + (bf) * SHM_V + vst1) = S.st_v1; } while (0)
#define SWRITE_H(bf) do { SWRITE_HV(bf); SWRITE_HK(bf); } while (0)
__device__ __forceinline__ void prime(const BlockRef& cur, char* lds, Seam& S, const int wid) {
    const int lane = lane_id(), tid = wid * 64 + lane, r32 = lane & 31, hi = lane >> 5;
    const int sr = tid >> 4, sc = (tid & 15) * 8, kws = KSWZ(sr, sc * 2); char* K_lds = lds + 2 * SHM_V;
    const int kb0 = cur.jlo * KVBLK;
#pragma unroll
    for (int d0 = 0; d0 < 8; ++d0) S.qr[d0] = LD8((const char*)(cur.Q + (size_t)(wid * QBLK) * NP) + (unsigned)((r32 * NP + hi * 8) * 2) + d0 * 32);
    const unsigned roff = (unsigned)(sr * cur.pkv + sc) * 2u;
    SLOAD_H(cur.K, cur.K + cur.voff, cur.pkv, kb0, roff); VMW(); SWRITE_HK(0);
    __syncthreads();
}
__device__ __forceinline__ void block(const BlockRef& cur, const BlockRef& nxt, char* lds, Seam& S, const int wid) {
    const int lane = lane_id(), tid = wid * 64 + lane, r32 = lane & 31, hi = lane >> 5;
    const int j_lo = cur.jlo;
    int j_hi = (cur.P0 + QB - 1) / KVBLK + 1; if (j_hi > cur.skv / KVBLK) j_hi = cur.skv / KVBLK;
    const int NT = j_hi - j_lo;
    const int kbn = nxt.jlo * KVBLK;
    const int qlo = cur.P0 + wid * QBLK, qm = qlo + r32 - 4 * hi;
    char* V_lds = lds; char* K_lds = lds + 2 * SHM_V;
    float* ws = (float*)(lds + 2 * SHM_V + 2 * SHM_K) + wid * 64; float* li_l = ws, * al_l = ws + 32;
    float* c_l = (float*)(lds + LDS_C);
#ifdef ATT_NO_BIAS
    if (0)
#endif
    {   const int n = j_hi * KVBLK; const float* Cg = cur.C; const float c0 = Cg[cur.c0i];
#pragma unroll 1
#ifdef ATT_BIAS_NOFILL
        for (int i = j_lo * KVBLK + tid; i < n; i += 512) c_l[i] = c0 * 0.f;
#else
        for (int i = j_lo * KVBLK + tid; i < n; i += 512) c_l[i] = (Cg[i] - c0) * (1.f / SCALE);
#endif
        __syncthreads(); }
#ifdef ATT_NO_BIAS
    const float cq = 0.f;
#else
    const float cq = c_l[cur.c0i + wid * QBLK + r32];
#endif
    float m_reg = -1e30f, l_reg = 0; f32x16 o[4] = {};
    const int sr = tid >> 4, sc = (tid & 15) * 8, vst0 = v_st(sr, sc), vst1 = v_st(32 + sr, sc), kws = KSWZ(sr, sc * 2);
    const int vb0 = (int)(uintptr_t)V_lds + v_rd_base(lane);
    const bf16_t* Kh = cur.K; const bf16_t* Vh = cur.K + cur.voff; const int pkv = cur.pkv; const unsigned roff = (unsigned)(sr * pkv + sc) * 2u;
#define RESC(a) do { if (__any((a) < 1.f)) { if (hi == 0) al_l[r32] = (a); asm volatile("s_waitcnt lgkmcnt(0)" ::: "memory");              \
                     for (int d_ = 0; d_ < 4; ++d_) for (int r = 0; r < 16; ++r) o[d_][r] *= al_l[crow(r, hi)]; } } while (0)
#define KBASE(t) ((j_lo + (t)) * KVBLK)
#define MASKT(P0_, P1_, t) do { const int kb_ = KBASE(t); if (kb_ + KVBLK - 1 > qlo) mask_tile(P0_, P1_, qm - kb_, WBIG); } while (0)
#define QKT(KB, P0_, P1_, t) qkt<KB>(P0_, P1_, K_lds, r32, hi, S.qr, c_l + KBASE(t) + 4 * hi, cq)
    constexpr int NQL = 8;
#define SEAM_K0() do { VMWN(NQL); SWRITE_HK(0); SBAR(); } while (0)
    f32x16 pA0, pA1, pB0, pB1; float mnA, mnB, alA, alB; bf16x8 pa0, pa1, pa2, pa3;
    SWRITE_HV(0); SBAR();
    if (NT > 1) { SLOAD_H(Kh, Vh, pkv, KBASE(1), roff); }
    SBAR(); QKT(0, pA0, pA1, 0);
    MASKT(pA0, pA1, 0); partialSM(pA0, pA1, m_reg, mnA, alA);
    if (NT > 1) { VMW(); SWRITE_H(1); }
    __syncthreads();
#define HALF_STEP(PX0, PX1, mnX, alX, PY0, PY1, alY, t, KB, VB, SB) do {                                                      \
        SBAR(); QKT(KB, PX0, PX1, t);                                                                                         \
        finishSM(PY0, PY1, alY, l_reg, pa0, pa1, pa2, pa3); SBAR();                                                           \
        if ((t) + 1 < NT) { SLOAD_H(Kh, Vh, pkv, KBASE((t) + 1), roff); SBAR(); }                                                   \
        pv_tile<VB>(o, vb0, pa0, pa1, pa2, pa3); MASKT(PX0, PX1, (t)); partialSM(PX0, PX1, m_reg, mnX, alX);                  \
        __syncthreads();                                                                                                      \
        if ((t) + 1 < NT) { VMW(); SWRITE_H(SB); }                                                                            \
        RESC(alX); __syncthreads(); } while (0)
    for (int t = 1; t + 1 < NT; t += 2) {
        HALF_STEP(pB0, pB1, mnB, alB, pA0, pA1, alA, t, 1, 0, 0);
        HALF_STEP(pA0, pA1, mnA, alA, pB0, pB1, alB, t + 1, 0, 1, 1);
    }
    const bool even = (NT & 1) == 0;
    if (even) { SBAR(); QKT(1, pB0, pB1, NT - 1); SBAR(); }
    { const unsigned roffn = (unsigned)(sr * nxt.pkv + sc) * 2u; SLOAD_H(nxt.K, nxt.K + nxt.voff, nxt.pkv, kbn, roffn); } SBAR();
#pragma unroll
    for (int d0 = 0; d0 < 8; ++d0) S.qr[d0] = LD8((const char*)(nxt.Q + (size_t)(wid * QBLK) * NP) + (unsigned)((r32 * NP + hi * 8) * 2) + d0 * 32);
    SBAR();
    finishSM(pA0, pA1, alA, l_reg, pa0, pa1, pa2, pa3); SBAR();
    pv_tile<0>(o, vb0, pa0, pa1, pa2, pa3);
    if (even) { MASKT(pB0, pB1, NT - 1); partialSM(pB0, pB1, m_reg, mnB, alB); __syncthreads(); RESC(alB);
        finishSM(pB0, pB1, alB, l_reg, pa0, pa1, pa2, pa3); SBAR(); pv_tile<1>(o, vb0, pa0, pa1, pa2, pa3); }
    SBAR(); SEAM_K0();
    int lane_e = lane; asm volatile("" : "+v"(lane_e));
    const int r32e = lane_e & 31, hie = lane_e >> 5;
    if (hie == 0) li_l[r32e] = l_reg; asm volatile("s_waitcnt lgkmcnt(0)" ::: "memory");
    float rli[16];
#pragma unroll
    for (int r = 0; r < 16; ++r) rli[r] = __builtin_amdgcn_rcpf(li_l[crow(r, hie)]);
    __syncthreads();
#ifndef ATT_NO_EPI
    bf16x8 gt[8];
    { const bf16_t* Gw = cur.Q + cur.goff + (size_t)(wid * QBLK + (lane_e >> 4)) * NP + (lane_e & 15) * 8;
#pragma unroll
      for (int i = 0; i < 8; ++i) gt[i] = LD8(Gw + (size_t)(i * 4) * NP); }
    SBAR();
    char* stg = lds + LDS_C + wid * 8704;
#pragma unroll
    for (int r = 0; r < 16; ++r) { const int orow = crow(r, hie);
#pragma unroll
        for (int d0 = 0; d0 < 4; ++d0) *(bf16_t*)(stg + orow * 272 + (d0 * 32 + r32e) * 2) = (bf16_t)f2bf(o[d0][r] * rli[r]); }
    asm volatile("s_waitcnt lgkmcnt(0)" ::: "memory");
    { bf16_t* Ow = cur.O + (size_t)(wid * QBLK + (lane_e >> 4)) * DM + (lane_e & 15) * 8;
#pragma unroll
      for (int i = 0; i < 8; ++i) { const bf16x8 ov = *(const bf16x8*)(stg + (i * 4 + (lane_e >> 4)) * 272 + (lane_e & 15) * 16); float v[8];
#pragma unroll
          for (int e = 0; e < 8; ++e) { const float g = bf2f((unsigned short)gt[i][e]); v[e] = bf2f((unsigned short)ov[e]) * g; }
          u32x4 w = {cvtpk(v[0], v[1]), cvtpk(v[2], v[3]), cvtpk(v[4], v[5]), cvtpk(v[6], v[7])};
          *(u32x4*)(Ow + (size_t)(i * 4) * DM) = w; } }
#endif
    __syncthreads();
#undef RESC
#undef KBASE
#undef MASKT
#undef QKT
#undef SEAM_K0
#undef HALF_STEP
}
#undef VMW
#undef VMWN
#undef SLOAD_H
#undef SWRITE_HK
#undef SWRITE_HV
#undef SWRITE_H
}

__device__ __forceinline__ int compute_jlo(const att::BlockRef& r, char* lds, int wid) {
    if (r.P0 >= SEQ) return 0;
    const int lane_ = lane_id(), tid_ = wid * 64 + lane_;
    const float* Cg = r.C; const float* QN = Cg + 8 * SEQ; const float* KN = Cg + 16 * SEQ;
    float* red = (float*)(lds + 138240);
    float qm = 0.f, km = 0.f;
    if (tid_ < 256) { qm = QN[r.P0 + tid_]; km = KN[r.P0 + tid_]; }
#pragma unroll
    for (int o = 1; o < 64; o <<= 1) { qm = fmaxf(qm, __shfl_xor(qm, o)); km = fmaxf(km, __shfl_xor(km, o)); }
    if (lane_ == 0) { red[wid] = qm; red[8 + wid] = km; }
    __syncthreads();
    qm = fmaxf(fmaxf(red[0], red[1]), fmaxf(red[2], red[3])); km = fmaxf(fmaxf(red[8], red[9]), fmaxf(red[10], red[11]));
    const float A = att::SCALE * 1.02f * sqrtf(qm), Kd = 1.02f * sqrtf(km), c0 = Cg[r.P0], THETA = 30.f;
    int smin = r.P0;
    for (int s = tid_; s < r.P0; s += 512) { const float thr = A * (1.02f * sqrtf(KN[s]) + Kd) + THETA; if (!(Cg[s] - c0 >= thr)) smin = min(smin, s); }
#pragma unroll
    for (int o = 1; o < 64; o <<= 1) smin = min(smin, __shfl_xor(smin, o));
    __syncthreads();
    if (lane_ == 0) ((int*)red)[16 + wid] = smin;
    __syncthreads();
    const int* ri = (const int*)red + 16;
    smin = min(min(min(ri[0], ri[1]), min(ri[2], ri[3])), min(min(ri[4], ri[5]), min(ri[6], ri[7])));
    return smin / att::KVBLK;
}

__device__ __forceinline__ bool get_attn(int b, int n, unsigned char* ws, att::BlockRef& r) {
    const bf16_t* P = (const bf16_t*)(ws + WS_P); bf16_t* Y = (bf16_t*)(ws + WS_Y);
#ifdef PROBE_DUPFOX
    if (n >= 1) --n;
    else n = 0;
#endif
    if (n == 0) {
        const int h = b & 7, qb = 31 - (b >> 3);
        r.Q = P + (size_t)(qb * 256) * NP + C_FQ + h * 128; r.K = (const bf16_t*)(ws + WS_KVH) + (size_t)h * SEQ * 128; r.voff = 8 * SEQ * 128; r.goff = C_FG - C_FQ;
        r.C = (const float*)(ws + WS_CS) + h * SEQ; r.O = Y + (size_t)(qb * 256) * DM + Y_FOX + h * 128; r.P0 = qb * 256; r.skv = SEQ; r.pkv = 128; r.jlo = 0; r.c0i = qb * 256; return true; }
    if (n == 1 && b >= 128) {
        const int m = 255 - b, h = m & 3, qb = m >> 2; const bf16_t* MKV = (const bf16_t*)(ws + WS_MKV);
        r.Q = P + (size_t)(qb * 256) * NP + C_MQ + h * 128; r.K = MKV + h * 128; r.voff = 512; r.goff = C_MG - C_MQ;
        r.C = (const float*)(ws + WS_SS); r.O = Y + (size_t)(qb * 256) * DM + Y_MEM + h * 128; r.P0 = 1 << 20; r.skv = MEMLEN; r.pkv = 1024; r.jlo = 0; r.c0i = 0; return true; }
    return false;
}

__device__ __forceinline__ void conv_item(int t0, const bf16_t* P, const float* conv_w, const float* conv_b, const float* ln_g, const float* ln_b,
                                          const bf16_t* WpwT, bf16_t* Y, char* lds, const int wid) {
    const int lane = lane_id(), tid = wid * 64 + lane;
    float* U = (float*)lds; float* Yc = (float*)lds; float* stat = (float*)(lds + 129024); bf16_t* At = (bf16_t*)lds;
    const int r32 = lane & 31, hi = lane >> 5, nb = wid * 64;
    const bf16_t* w0p = WpwT + (size_t)(nb + r32) * 512 + hi * 8; const bf16_t* w1p = w0p + 32 * 512;
    bf16x8 wA[16], wB[16];
#define WLOAD(dst, batch) do { _Pragma("unroll") for (int q_ = 0; q_ < 8; ++q_) { dst[2 * q_] = LD8(w0p + ((batch) * 8 + q_) * 16); dst[2 * q_ + 1] = LD8(w1p + ((batch) * 8 + q_) * 16); } } while (0)
    WLOAD(wA, 0);
#pragma unroll
    for (int i = 0; i < 8; ++i) { const int idx = tid + i * 512, r = idx >> 6, ch = (idx & 63) * 8;
        if (r < 62) { const int tok = t0 - 30 + r; f32x4 u0 = {0.f, 0.f, 0.f, 0.f}, u1 = u0;
            if (tok >= 0) { const bf16x8 a = LD8(P + (size_t)tok * NP + (ch >> 7) * 256 + (ch & 127));
#pragma unroll
                for (int e = 0; e < 4; ++e) { u0[e] = bf2f((unsigned short)a[e]); u1[e] = bf2f((unsigned short)a[4 + e]); } }
            *(f32x4*)(U + r * 512 + ch) = u0; *(f32x4*)(U + r * 512 + ch + 4) = u1; } }
    __syncthreads();
    const int c = tid;
    float acc[32];
    { float w[31];
#pragma unroll
      for (int k = 0; k < 31; ++k) w[k] = conv_w[k * 512 + c];
      const float bias = conv_b[c];
#pragma unroll
      for (int t = 0; t < 32; ++t) acc[t] = bias;
#pragma unroll
      for (int r = 0; r < 62; ++r) { const float uv = U[r * 512 + c];
#pragma unroll
          for (int t = 0; t < 32; ++t) { if (r - t >= 0 && r - t <= 30) acc[t] = fmaf(w[r - t], uv, acc[t]); } } }
    __syncthreads();
#pragma unroll
    for (int t = 0; t < 32; ++t) Yc[t * 512 + c] = acc[t];
    __syncthreads();
#pragma unroll
    for (int q = 0; q < 4; ++q) { const int t = wid * 4 + q; const f32x4 a = *(const f32x4*)(Yc + t * 512 + lane * 8), bq = *(const f32x4*)(Yc + t * 512 + lane * 8 + 4);
        float s1 = (a[0] + a[1]) + (a[2] + a[3]) + (bq[0] + bq[1]) + (bq[2] + bq[3]);
        float s2 = (a[0] * a[0] + a[1] * a[1]) + (a[2] * a[2] + a[3] * a[3]) + (bq[0] * bq[0] + bq[1] * bq[1]) + (bq[2] * bq[2] + bq[3] * bq[3]);
#pragma unroll
        for (int o = 1; o < 64; o <<= 1) { s1 += __shfl_xor(s1, o); s2 += __shfl_xor(s2, o); }
        if (lane == 0) { const float mean = s1 * (1.f / 512.f), var = s2 * (1.f / 512.f) - mean * mean; stat[t * 2] = mean; stat[t * 2 + 1] = rsqrtf(fmaxf(var, 0.f) + EPS); } }
    __syncthreads();
    { const float g = ln_g[c], be = ln_b[c];
#pragma unroll
        for (int t = 0; t < 32; ++t) { const float y = (acc[t] - stat[2 * t]) * stat[2 * t + 1] * g + be; At[t * 520 + c] = (bf16_t)f2bf(y * sigmoidf_(y)); } }
    s16x4 gt[8];
    { const int tok = t0 + r32;
#pragma unroll
      for (int blk = 0; blk < 2; ++blk)
#pragma unroll
          for (int g4 = 0; g4 < 4; ++g4) gt[blk * 4 + g4] = *(const s16x4*)(P + (size_t)tok * NP + C_CVG + nb + blk * 32 + 8 * g4 + 4 * hi); }
    __syncthreads();
    f32x16 o0 = {}, o1 = {};
    const bf16_t* ap = At + r32 * 520 + hi * 8;
#define WMMA(src, batch) do { _Pragma("unroll") for (int q_ = 0; q_ < 8; ++q_) { const bf16x8 zf = LD8(ap + ((batch) * 8 + q_) * 16); \
        o0 = __builtin_amdgcn_mfma_f32_32x32x16_bf16(src[2 * q_], zf, o0, 0, 0, 0); o1 = __builtin_amdgcn_mfma_f32_32x32x16_bf16(src[2 * q_ + 1], zf, o1, 0, 0, 0); } } while (0)
    WLOAD(wB, 1); WMMA(wA, 0);
    WLOAD(wA, 2); WMMA(wB, 1);
    WLOAD(wB, 3); WMMA(wA, 2);
    WMMA(wB, 3);
#undef WLOAD
#undef WMMA
    { const int tok = t0 + r32;
#pragma unroll
        for (int blk = 0; blk < 2; ++blk)
#pragma unroll
            for (int g4 = 0; g4 < 4; ++g4) { const int n = nb + blk * 32 + 8 * g4 + 4 * hi; const s16x4 gtv = gt[blk * 4 + g4];
                float v[4];
#pragma unroll
                for (int j = 0; j < 4; ++j) { const float gv = bf2f((unsigned short)gtv[j]); v[j] = (blk ? o1[4 * g4 + j] : o0[4 * g4 + j]) * gv; }
                u32x2 pk; pk.x = pk2(v[0], v[1]); pk.y = pk2(v[2], v[3]); *(u32x2*)(Y + (size_t)tok * DM + Y_CONV + n) = pk; } }
    __syncthreads();
}

struct TrItem { const float* src; bf16_t* dst; int srcN, K; };
__device__ __forceinline__ void tr_decode(int it, const float* w_in, const float* w_kv, const float* w_out, const float* w_pw, unsigned char* ws, TrItem& t) {
    constexpr int I_IN = 32 * (NP / 32), I_KV = 32 * 32, I_OUT = 32 * 64;
    const float* W; bf16_t* WT; int srcN, K, ncols, shift = 1 << 30, r = it;
    if (r < I_IN) { W = w_in; WT = (bf16_t*)(ws + WS_B); srcN = DIN; K = DM; ncols = NP; shift = FCOL; }
    else if (r < I_IN + I_KV) { r -= I_IN; W = w_kv; WT = (bf16_t*)(ws + WS_WKV); srcN = 1024; K = DM; ncols = 1024; }
    else if (r < I_IN + I_KV + I_OUT) { r -= I_IN + I_KV; W = w_out; WT = (bf16_t*)(ws + WS_WOUT); srcN = DM; K = DM; ncols = DM; }
    else { r -= I_IN + I_KV + I_OUT; W = w_pw; WT = (bf16_t*)(ws + WS_WPW); srcN = 512; K = 512; ncols = 512; }
    const int nblk = ncols / 32, kb = r / nblk, nb = r % nblk, k0 = 64 * kb, n0 = 32 * nb;
    int sn0 = n0 + (n0 >= shift ? 8 : 0);
    if (W == w_in && n0 < 1024) sn0 = ((n0 & 255) >> 7) * 512 + (n0 >> 8) * 128 + (n0 & 127);
    t.src = W + (size_t)k0 * srcN + sn0; t.dst = WT + (size_t)n0 * K + k0; t.srcN = srcN; t.K = K;
}
__device__ __forceinline__ void tr_load(float (&buf)[32], const TrItem& t, int lane) {
    const float* p = t.src + (size_t)(lane >> 5) * t.srcN + (lane & 31);
#pragma unroll
    for (int i = 0; i < 32; ++i) buf[i] = __builtin_nontemporal_load(p + (size_t)(2 * i) * t.srcN);
}
__device__ __forceinline__ void tr_store(const float (&buf)[32], const TrItem& t, float* scr, int lane) {
#pragma unroll
    for (int i = 0; i < 32; ++i) scr[(2 * i + (lane >> 5)) * 33 + (lane & 31)] = buf[i];
    asm volatile("s_waitcnt lgkmcnt(0)" ::: "memory");
    const int c = lane & 7;
#pragma unroll
    for (int j = 0; j < 4; ++j) { const int n = (lane >> 3) + 8 * j; const float* s = scr + (8 * c) * 33 + n;
        u32x4 o; o.x = pk2(s[0 * 33], s[1 * 33]); o.y = pk2(s[2 * 33], s[3 * 33]); o.z = pk2(s[4 * 33], s[5 * 33]); o.w = pk2(s[6 * 33], s[7 * 33]);
        *(u32x4*)(t.dst + (size_t)n * t.K + 8 * c) = o; }
    asm volatile("s_waitcnt lgkmcnt(0)" ::: "memory");
}
__device__ __forceinline__ void transposes(int it0, int it1, int gw, int NGW, const float* w_in, const float* w_kv, const float* w_out, const float* w_pw, unsigned char* ws, float* scr, int lane) {
    TrItem tc, tn; float bc[32], bn[32]; int it = it0 + gw;
    if (it < it1) { tr_decode(it, w_in, w_kv, w_out, w_pw, ws, tc); tr_load(bc, tc, lane); }
    while (it < it1) { const int itn = it + NGW; const bool hn = itn < it1;
        if (hn) { tr_decode(itn, w_in, w_kv, w_out, w_pw, ws, tn); tr_load(bn, tn, lane); }
        tr_store(bc, tc, scr, lane);
        if (hn) { tc = tn;
#pragma unroll
            for (int i = 0; i < 32; ++i) bc[i] = bn[i]; }
        it = itn; }
}
__device__ __forceinline__ void norm_row(f32x4 (&v)[8], const f32x4 (&gv)[8], bf16_t* orow, int lane, const float* wf_lds, f32x4* rowbuf, const float* b_f, float* logf_out  ) {
    float s = 0.f;
#pragma unroll
    for (int j = 0; j < 8; ++j) s += (v[j].x * v[j].x + v[j].y * v[j].y) + (v[j].z * v[j].z + v[j].w * v[j].w);
    const float rstd = rsqrtf(wave_sum(s) * (1.f / DM) + EPS);
#pragma unroll
    for (int j = 0; j < 8; ++j) v[j] = v[j] * rstd * gv[j];
    unsigned long long* o8 = (unsigned long long*)orow + lane;
#pragma unroll
    for (int j = 0; j < 8; ++j) o8[64 * j] = (unsigned long long)pk2(v[j].x, v[j].y) | ((unsigned long long)pk2(v[j].z, v[j].w) << 32);
    if (wf_lds) {
#pragma unroll
        for (int j = 0; j < 8; ++j) rowbuf[64 * j + lane] = v[j];
        asm volatile("s_waitcnt lgkmcnt(0)" ::: "memory");
        f32x4 f0 = {0.f, 0.f, 0.f, 0.f}, f1 = f0; const f32x4* wf = (const f32x4*)wf_lds + lane;
#pragma unroll 1
        for (int j = 0; j < 8; ++j) { const f32x4 hv = rowbuf[64 * j + lane]; const f32x4* wj = wf + 512 * j;
#pragma unroll
            for (int i = 0; i < 4; ++i) { f0 += hv[i] * wj[128 * i]; f1 += hv[i] * wj[128 * i + 64]; } }
        float f[8] = {f0[0], f0[1], f0[2], f0[3], f1[0], f1[1], f1[2], f1[3]};
        float zsel = 0.f;
#pragma unroll
        for (int h = 0; h < 8; ++h) { const float z = wave_sum(f[h]) + b_f[h]; zsel = (lane == h) ? z : zsel; }
        const float ls = fminf(zsel, 0.f) - log1pf(__expf(-fabsf(zsel)));
        if (lane < 8) logf_out[(size_t)lane * SEQ] = ls;
    }
}
__device__ __forceinline__ void row_load(f32x4 (&v)[8], const float* row, int lane) {
    const f32x4* xr = (const f32x4*)row + lane;
#pragma unroll
    for (int j = 0; j < 8; ++j) v[j] = __builtin_nontemporal_load(xr + 64 * j);
}

__device__ __forceinline__ const void* lds_ptr(const unsigned char* lds, int k) {
    const unsigned lo = *(const volatile unsigned*)(lds + 146944 + 8 * k), hi = *(const volatile unsigned*)(lds + 146944 + 8 * k + 4);
    return (const void*)(((unsigned long long)(unsigned)__builtin_amdgcn_readfirstlane((int)hi) << 32) | (unsigned)__builtin_amdgcn_readfirstlane((int)lo));
}
#define GAS __attribute__((address_space(1)))
#define XB_TMO      128
#define XB_XCNT(j)  (256  + 64 * (j))
#define XB_XSUB(j)  (1280 + 64 * (j))
#define XB_XGEN(j)  (2304 + 64 * (j))
#define XB_TOP      3328
#define XB_TOPGEN   3392
#define XCD_BAR_WORDS 3456
#define XB_SPIN_CAP (1u << 18)

__device__ __forceinline__ unsigned xb_ld(unsigned* p)              { return __hip_atomic_load(p, __ATOMIC_RELAXED, __HIP_MEMORY_SCOPE_AGENT); }
__device__ __forceinline__ unsigned xb_add(unsigned* p, unsigned v) { return __hip_atomic_fetch_add(p, v, __ATOMIC_RELAXED, __HIP_MEMORY_SCOPE_AGENT); }
__device__ __forceinline__ unsigned xb_xcc_id() { return (unsigned)__builtin_amdgcn_s_getreg((3 << 11) | 20) & 0xFu; }
#define XB_SPIN(cond, bar) do { unsigned _sp = 0; while (cond) { __builtin_amdgcn_s_sleep(1); \
    if ((++_sp & 255u) == 0u) { if (xb_ld(&(bar)[XB_TMO])) break; if (_sp > XB_SPIN_CAP) { atomicAdd(&(bar)[XB_TMO], 1u); break; } } } } while (0)

struct XcdBarrier {
    unsigned* bar; unsigned x;
    volatile LAS unsigned* st;
};

__device__ __forceinline__ XcdBarrier xcd_barrier_post(unsigned* bar, volatile LAS unsigned* st, bool is0) {
    XcdBarrier b; b.bar = bar; b.x = xb_xcc_id(); b.st = st;
    if (is0) (void)xb_add(&bar[XB_XCNT(b.x)], 1u);
    return b;
}
__device__ __forceinline__ void xcd_barrier_complete(unsigned* bar, unsigned x, unsigned& nloc, unsigned& nx) {
    const unsigned G = gridDim.x * gridDim.y * gridDim.z;
    unsigned sum, cnt, mine, sp = 0u;
    for (;;) {
        sum = 0u; cnt = 0u; mine = 0u;
#pragma unroll
        for (unsigned j = 0; j < 16; ++j) { const unsigned c = xb_ld(&bar[XB_XCNT(j)]); sum += c; cnt += (c > 0u) ? 1u : 0u; mine = (j == x) ? c : mine; }
        if (sum == G) break;
        __builtin_amdgcn_s_sleep(1);
        if ((++sp & 255u) == 0u) { if (xb_ld(&bar[XB_TMO])) break; if (sp > XB_SPIN_CAP) { atomicAdd(&bar[XB_TMO], 1u); break; } }
    }
    nloc = mine > 0u ? mine : 1u; nx = cnt > 0u ? cnt : 1u;
}

__device__ __forceinline__ void xcd_barrier(const XcdBarrier& b, bool is0) {
    asm volatile("s_waitcnt vmcnt(0)" ::: "memory");
    __syncthreads();
    if (is0) {
        unsigned* bar = b.bar;
        __builtin_amdgcn_s_waitcnt(0);
        unsigned nloc = b.st[0], nx = b.st[1];
        if (nloc == 0u) { xcd_barrier_complete(bar, b.x, nloc, nx); b.st[0] = nloc; b.st[1] = nx; }
        const unsigned old = xb_add(&bar[XB_XSUB(b.x)], 1u);
        const unsigned gen = old / nloc;
        if (old + 1u == (gen + 1u) * nloc) {
            __builtin_amdgcn_fence(__ATOMIC_RELEASE, "agent");
            asm volatile("s_waitcnt vmcnt(0)" ::: "memory");
            const unsigned og = xb_add(&bar[XB_TOP], 1u);
            const unsigned tg = og / nx;
            if (og + 1u == (tg + 1u) * nx) xb_add(&bar[XB_TOPGEN], 1u);
            else XB_SPIN(xb_ld(&bar[XB_TOPGEN]) == tg, bar);
            __builtin_amdgcn_fence(__ATOMIC_ACQUIRE, "agent");
            xb_add(&bar[XB_XGEN(b.x)], 1u);
            asm volatile("s_waitcnt vmcnt(0)" ::: "memory");
        } else {
            XB_SPIN(xb_ld(&bar[XB_XGEN(b.x)]) == gen, bar);
            __builtin_amdgcn_fence(__ATOMIC_ACQUIRE, "agent");
            asm volatile("s_waitcnt vmcnt(0)" ::: "memory");
        }
    }
    __syncthreads();
}

__device__ __forceinline__ void phase_attn(int b, unsigned char* ws, unsigned char* lds, int wave) {
    att::Seam S; att::BlockRef cur, nxt; int n = 0;
    if (get_attn(b, 0, ws, cur)) {
        cur.jlo = compute_jlo(cur, (char*)lds, wave);
        att::prime(cur, (char*)lds, S, wave);
        for (;;) { const bool more = get_attn(b, n + 1, ws, nxt); if (!more) nxt = cur;
#ifdef PROBE_DUPFOX
            if (more && nxt.P0 < SEQ) nxt.jlo = cur.jlo;
#endif
            att::block(cur, nxt, (char*)lds, S, wave);
            if (!more) break; cur = nxt; ++n; }
    }
    asm volatile("s_waitcnt vmcnt(0)" ::: "memory");
    __syncthreads();
}
__device__ __forceinline__ void phase_conv(int b, unsigned char* ws, unsigned char* lds, int wave) {
    const float* conv_w = (const float*)lds_ptr(lds, 6); const float* conv_b = (const float*)lds_ptr(lds, 7); const float* conv_ln_g = (const float*)lds_ptr(lds, 8); const float* conv_ln_b = (const float*)lds_ptr(lds, 9);
    conv_item(b * 32, (const bf16_t*)(ws + WS_P), conv_w, conv_b, conv_ln_g, conv_ln_b, (const bf16_t*)(ws + WS_WPW), (bf16_t*)(ws + WS_Y), (char*)lds, wave);
}
#ifdef DUP_P3
#define P3_SS_SCALE 0.5f
#else
#define P3_SS_SCALE 1.f
#endif
struct Args { const float* in[14]; float* out; unsigned char* ws; int ph_lo, ph_hi; };
__global__ void __launch_bounds__(512, 2) fwd_kernel(Args a) {
    extern __shared__ __attribute__((aligned(16))) unsigned char lds[];
    if (a.ph_hi > 1000) { cg::grid_group grid = cg::this_grid(); grid.sync(); }
    const int wave = __builtin_amdgcn_readfirstlane((int)(threadIdx.x >> 6));
#define lane lane_id()
#define tid (wave * 64 + lane_id())
    const int G = gridDim.x, b = blockIdx.x;
    unsigned char* ws = a.ws;
    if (threadIdx.x < 14) ((const float**)(lds + 146944))[threadIdx.x] = a.in[threadIdx.x];
    if (threadIdx.x < 2) ((unsigned*)(lds + 146944 + 128))[threadIdx.x] = 0u;
    __syncthreads();
#define ARGP(k) ((const float*)lds_ptr(lds, (k)))
    XcdBarrier bar = xcd_barrier_post((unsigned*)(ws + WS_BAR), (volatile LAS unsigned*)(lds + 146944 + 128), wave == 0 && lane_id() == 0);
    const int lo = a.ph_lo, hi = a.ph_hi;
#ifdef DBG_PHASE
    unsigned long long tstamp[6]; tstamp[0] = __builtin_amdgcn_s_memrealtime();
#define STAMP(k) tstamp[k] = __builtin_amdgcn_s_memrealtime()
#else
#define STAMP(k)
#endif
#define IN(k) (lo <= (k) && (k) < hi)
#define BOTH(k) (IN(k) && IN((k) + 1))

#ifndef SKIP_P0
#ifdef DUP_P0
    for (int rep_ = 0; rep_ < 2; ++rep_)
#endif
    if (IN(0)) {
        const float* x = ARGP(0); const float* mem = ARGP(1); const float* norm_g = ARGP(2); const float* mem_norm_g = ARGP(3); const float* w_in = ARGP(4); const float* b_f = ARGP(5);
        const float* w_conv_pw = ARGP(10); const float* w_mem_kv = ARGP(11); const float* w_out = ARGP(12);
        float* ss = (float*)(ws + WS_SS);
        for (int i = b * 512 + tid; i < SEQ; i += G * 512) ss[i] = 0.f;
        { float* qn = (float*)(ws + WS_QN2); for (int i = b * 512 + tid; i < 16 * SEQ; i += G * 512) qn[i] = 0.f; }
        float* wf = (float*)(lds + 73728);
        f32x4 wfr[8];
#pragma unroll
        for (int q = 0; q < 8; ++q) { const int idx = tid + q * 512, k = idx >> 1, half = idx & 1; wfr[q] = *(const f32x4*)(w_in + (size_t)k * DIN + FCOL + half * 4); }
        const int gw = b * 8 + wave, NGW = G * 8;
        bf16_t* XB = (bf16_t*)(ws + WS_A); bf16_t* MEMN = (bf16_t*)(ws + WS_MEMN); float* LOGF = (float*)(ws + WS_LOGF);
#ifndef SKIP_TR
        transposes(0, 32 * (NP / 32) + 32 * 32, gw, NGW, w_in, w_mem_kv, w_out, w_conv_pw, ws, (float*)(lds + wave * 8448), lane);
#endif
#pragma unroll
        for (int q = 0; q < 8; ++q) { const int idx = tid + q * 512, k = idx >> 1, half = idx & 1, j = k >> 8, l = (k >> 2) & 63, i = k & 3;
            *(f32x4*)(wf + ((((j * 4 + i) * 2 + half) * 64 + l) << 2)) = wfr[q]; }
        __syncthreads();
#ifndef SKIP_ROWS
        {   f32x4* rowbuf = (f32x4*)(lds + wave * 8448);
            f32x4 gv[8], r0[8], r1[8], r2[8], r3[8];
            for (int m0 = gw * 4; m0 < SEQ; m0 += NGW * 4) {
                row_load(r0, x + (size_t)m0 * DM, lane); row_load(r1, x + (size_t)(m0 + 1) * DM, lane); row_load(r2, x + (size_t)(m0 + 2) * DM, lane); row_load(r3, x + (size_t)(m0 + 3) * DM, lane);
                row_load(gv, norm_g, lane);
                norm_row(r0, gv, XB + (size_t)m0 * DM, lane, wf, rowbuf, b_f, LOGF + m0);
                norm_row(r1, gv, XB + (size_t)(m0 + 1) * DM, lane, wf, rowbuf, b_f, LOGF + m0 + 1);
                norm_row(r2, gv, XB + (size_t)(m0 + 2) * DM, lane, wf, rowbuf, b_f, LOGF + m0 + 2);
                norm_row(r3, gv, XB + (size_t)(m0 + 3) * DM, lane, wf, rowbuf, b_f, LOGF + m0 + 3); }
            if (gw < MEMLEN) { row_load(gv, mem_norm_g, lane); row_load(r0, mem + (size_t)gw * DM, lane); norm_row(r0, gv, MEMN + (size_t)gw * DM, lane, nullptr, rowbuf, nullptr, nullptr); }
        }
#endif
#ifdef DBG_PHASE
        tstamp[5] = __builtin_amdgcn_s_memrealtime();
#endif
    }
#endif
    if (BOTH(0)) xcd_barrier(bar, wave == 0 && lane_id() == 0);
#ifdef PROBE_XBAR
    for (int q_ = 0; q_ < 4; ++q_) xcd_barrier(bar, wave == 0 && lane_id() == 0);
#endif
    STAMP(1);

#ifndef SKIP_P1
    if (IN(1)) {
        pg8::Gemm g{(const pg8::bf16_t*)(ws + WS_A), (const pg8::bf16_t*)(ws + WS_B), SEQ + 256, NP + 1024, DM};
        { Sched1 S{G, b, 3}; Epi1 E{(bf16_t*)(ws + WS_P), (bf16_t*)(ws + WS_MKV), (float*)(ws + WS_QN2), (bf16_t*)(ws + WS_KVH)};
          pg8::gemm_phase<Epi1, Sched1, true, true>((LAS unsigned char*)lds, g, S, E, wave); }
        if (b < 136) { SchedTail S{b}; Epi1H E{(bf16_t*)(ws + WS_P), (bf16_t*)(ws + WS_MKV), (float*)(ws + WS_QN2), (bf16_t*)(ws + WS_KVH)};
          pg8::gemm_phase<Epi1H, SchedTail, true, true, true>((LAS unsigned char*)lds, g, S, E, wave); }
        else {
            const int nidle = G - 136, gwi = (b - 136) * 8 + wave;
            __syncthreads();
            transposes(32 * (NP / 32) + 32 * 32, 32 * (NP / 32) + 32 * 32 + 32 * 64 + 8 * 16, gwi, nidle * 8, ARGP(4), ARGP(11), ARGP(12), ARGP(10), ws, (float*)(lds + wave * 8448), lane);
            __syncthreads();
            if (b >= 248) {
                const int hb = b - 248;
                const float* lf = (const float*)(ws + WS_LOGF) + (size_t)hb * SEQ; float* cs = (float*)(ws + WS_CS) + (size_t)hb * SEQ; float* wt = (float*)lds;
                f32x4 v[4]; float run = 0.f;
    #pragma unroll
                for (int j = 0; j < 4; ++j) { v[j] = *(const f32x4*)(lf + tid * 16 + j * 4);
                    v[j].x += run; v[j].y += v[j].x; v[j].z += v[j].y; v[j].w += v[j].z; run = v[j].w; }
                float inc = run;
    #pragma unroll
                for (int o = 1; o < 64; o <<= 1) { const float t = __shfl_up(inc, o); if (lane >= o) inc += t; }
                if (lane == 63) wt[wave] = inc;
                __syncthreads();
                float off = inc - run;
                for (int wv = 0; wv < wave; ++wv) off += wt[wv];
    #pragma unroll
                for (int j = 0; j < 4; ++j) *(f32x4*)(cs + tid * 16 + j * 4) = v[j] + off;
                __syncthreads();
            }
        }
#ifdef DUP_P1
        pg8::gemm_phase<Epi1, Sched1, true, true>((LAS unsigned char*)lds, g, S, E, wave);
#endif
    }
#endif
    if (BOTH(1)) xcd_barrier(bar, wave == 0 && lane_id() == 0);
    STAMP(2);

#ifndef SKIP_P2
    if (IN(2)) {
#ifndef SKIP_ATT
#ifdef DUP_ATT
#pragma unroll 1
        for (int rep_ = 0; rep_ < 2; ++rep_)
#endif
        phase_attn(b, ws, lds, wave);
#endif
#ifndef SKIP_CONV
        phase_conv(b, ws, lds, wave);
#ifdef DUP_CONV
        phase_conv(b, ws, lds, wave);
#endif
#endif
    }
#endif
    if (BOTH(2)) xcd_barrier(bar, wave == 0 && lane_id() == 0);
    STAMP(3);

#ifndef SKIP_P3
    if (IN(3)) {
        pg8::Gemm g{(const pg8::bf16_t*)(ws + WS_Y), (const pg8::bf16_t*)(ws + WS_WOUT), SEQ, DM, DM};
        pg8::StaticOrder S; S.init(SEQ, DM, G, b); Epi2 E{ARGP(0), a.out, (float*)(ws + WS_SS), ARGP(13), (unsigned*)(ws + WS_BAR + 16384)};
        pg8::gemm_phase<Epi2, pg8::StaticOrder, false, true>((LAS unsigned char*)lds, g, S, E, wave);
#ifdef DUP_P3_DISABLED
        pg8::gemm_phase<Epi2, pg8::StaticOrder, true, true>((LAS unsigned char*)lds, g, S, E, wave);
#endif
    }
#endif
#ifdef DBG_PHASE
    STAMP(4);
    __syncthreads();
    if (b == 0 && tid == 0) { float code = 0.f;
        if ((float)(tstamp[5] - tstamp[0]) * 0.01f > (float)DBG_T0) code += 1000.f;
        if ((float)(tstamp[5] - tstamp[0]) * 0.01f > (float)DBG_T1) code += 2000.f;
        if ((float)(tstamp[1] - tstamp[0]) * 0.01f > (float)DBG_T2) code += 4000.f;
        if ((float)(tstamp[1] - tstamp[0]) * 0.01f > (float)DBG_T3) code += 8000.f;
        if (code > 0.f) a.out[0] = code; }
#endif
#undef IN
#undef BOTH
#undef lane
#undef tid
}

#ifndef PH_LO
#define PH_LO 0
#endif
#ifndef PH_HI
#define PH_HI 5
#endif
#ifndef N_LAUNCHES
#define N_LAUNCHES 1
#endif
extern "C" void kernel_launch(void* const* d_in, const int* in_sizes, int n_in, void* d_out, int out_size, void* d_ws, size_t ws_size, hipStream_t stream) {
    static int grid = 0;
    if (grid == 0) {
        if (n_in != 14 || out_size != SEQ * DM || ws_size < WS_END) { fprintf(stderr, "kernel_launch: unexpected shapes (n_in %d out %d ws %zu)\n", n_in, out_size, ws_size); grid = -1; return; }
        int dev = 0, cus = 0, per_cu = 0;
        (void)hipGetDevice(&dev); (void)hipDeviceGetAttribute(&cus, hipDeviceAttributeMultiprocessorCount, dev);
        if (hipFuncSetAttribute((const void*)fwd_kernel, hipFuncAttributeMaxDynamicSharedMemorySize, LDS_BYTES) != hipSuccess) { fprintf(stderr, "kernel_launch: hipFuncSetAttribute failed\n"); grid = -1; return; }
        if (hipOccupancyMaxActiveBlocksPerMultiprocessor(&per_cu, (const void*)fwd_kernel, 512, LDS_BYTES) != hipSuccess || per_cu < 1) per_cu = 1;
        (void)hipGetLastError();
        if (cus <= 0) cus = 256;
        grid = cus * per_cu; if (grid > 256) grid = 256;
        if (grid != 256) { fprintf(stderr, "kernel_launch: this kernel needs a 256-workgroup cooperative grid (got %d)\n", grid); grid = -1; return; }
    }
    if (grid < 0) return;
    if (hipMemsetAsync((char*)d_ws + WS_BAR, 0, 16384 + 32 * 256, stream) != hipSuccess) { fprintf(stderr, "kernel_launch: memset failed\n"); return; }
    Args a{};
    for (int i = 0; i < 14; ++i) a.in[i] = (const float*)d_in[i];
    a.out = (float*)d_out; a.ws = (unsigned char*)d_ws;
    for (int li = 0; li < N_LAUNCHES; ++li) {
        if (N_LAUNCHES == 1) { a.ph_lo = PH_LO; a.ph_hi = PH_HI > 4 ? 4 : PH_HI; } else { a.ph_lo = li; a.ph_hi = li + 1; }
        void* args[] = {&a};
        hipError_t e = hipLaunchCooperativeKernel((const void*)fwd_kernel, dim3(grid), dim3(512), args, LDS_BYTES, stream);
        if (e != hipSuccess) { fprintf(stderr, "kernel_launch: cooperative launch failed: %s (grid %d)\n", hipGetErrorString(e), grid); break; }
    }
}
```
